# Optimizing an MI355X kernel written in HIP

```python
import math
import jax
import jax.numpy as jnp
from jax import lax
import numpy as np

D_MODEL = 4096
BATCH = 2
SEQ = 4096
DEPTH = 2

GRID_W = 64
CTX_LEN = 256
N_GROUPS = 4
GROUP_W = D_MODEL // N_GROUPS
FNET_GROUPS = 4
FNET_GW = GROUP_W // FNET_GROUPS
HYENA_ORDER = 2
HYENA_BANDS = 16
HYENA_EMB = 2 * HYENA_BANDS + 1
HYENA_HID = 64
HYENA_FAST_DECAY = math.log(1e-2) / 0.3
HYENA_SLOW_DECAY = math.log(1e-2) / 1.5
SHORT_CONV = 3
MLSTM_HEADS = 4
MLSTM_DH = GROUP_W // MLSTM_HEADS
GLA_HEADS = 4
GLA_DV = GROUP_W // GLA_HEADS
GLA_DK = GLA_DV // 2
GLA_RANK = 16
GLA_TAU = 16.0
N_DIR = 2
CHUNK = 64
EPS = 1e-6
F32 = jnp.float32

PROJ_LAYOUT = (
    ("a_u", GROUP_W), ("a_g", GROUP_W),
    ("b_u", 3 * GROUP_W), ("b_g", GROUP_W),
    ("c_q", GROUP_W), ("c_k", GROUP_W), ("c_v", GROUP_W), ("c_o", GROUP_W), ("c_g", GROUP_W),
    ("c_if", N_DIR * 2 * MLSTM_HEADS),
    ("d_q", GLA_HEADS * GLA_DK), ("d_k", GLA_HEADS * GLA_DK), ("d_v", GROUP_W), ("d_g", GROUP_W),
    ("d_a", N_DIR * GLA_RANK),
)
PROJ_W = sum(w for _, w in PROJ_LAYOUT)
CTX_STATE_NAMES = ("c_k", "c_v", "c_if", "d_k", "d_v", "d_a")

kernel_name = "hybrid_parallel_mixer_dit"


def rmsnorm(x, g):
    xf = x.astype(F32)
    y = xf * lax.rsqrt(jnp.mean(xf * xf, axis=-1, keepdims=True) + EPS)
    return (y * g.astype(F32)).astype(x.dtype)


def project(h, w_in, names):
    slices, off = {}, 0
    for name, w in PROJ_LAYOUT:
        slices[name] = (off, off + w)
        off += w
    if names is None:
        z = h @ w_in
        return {n: z[..., a:b] for n, (a, b) in slices.items()}
    return {n: h @ w_in[:, slices[n][0]:slices[n][1]] for n in names}


def short_conv(x, w, b):
    xp = jnp.pad(x, ((0, 0), (1, 1), (0, 0)))
    return xp[:, :-2] * w[0] + xp[:, 1:-1] * w[1] + xp[:, 2:] * w[2] + b


def to_col_major(a, rows):
    b, l, c = a.shape
    return a.reshape(b, rows, GRID_W, c).transpose(0, 2, 1, 3).reshape(b, l, c)


def from_col_major(a, rows):
    b, l, c = a.shape
    return a.reshape(b, GRID_W, rows, c).transpose(0, 2, 1, 3).reshape(b, l, c)


def merge_heads(o):
    b, h, l, d = o.shape
    return o.transpose(0, 2, 1, 3).reshape(b, l, h * d)


def flip_t(a):
    return None if a is None else jnp.flip(a, axis=2)


def fourier_mix(u, w):
    b, l, _ = u.shape
    uf = u.astype(F32).reshape(b, l, FNET_GROUPS, FNET_GW)
    y = jnp.fft.fftn(uf, axes=(1, 3), norm="ortho").real.reshape(b, l, GROUP_W)
    return y @ w.astype(F32)


def hyena_filter_spectrum(l, p):
    t = jnp.linspace(0.0, 1.0, l, dtype=F32)[:, None]
    bands = jnp.linspace(1e-4, HYENA_BANDS - 1, HYENA_BANDS, dtype=F32)[None, :]
    ang = (2.0 * math.pi / l) * jnp.arange(l, dtype=F32)[:, None] * bands
    feats = jnp.concatenate([t, jnp.cos(ang), -jnp.sin(ang)], axis=-1)
    fr = p["hy_f_freq"].astype(F32)
    hid = jnp.sin(fr[0] * (feats @ p["hy_f_w1"].astype(F32) + p["hy_f_b1"].astype(F32)))
    hid = jnp.sin(fr[1] * (hid @ p["hy_f_w2"].astype(F32) + p["hy_f_b2"].astype(F32)))
    filt = (hid @ p["hy_f_w3"].astype(F32)).reshape(l, HYENA_ORDER, N_DIR, GROUP_W)
    deltas = jnp.abs(jnp.linspace(HYENA_SLOW_DECAY, HYENA_FAST_DECAY, GROUP_W, dtype=F32))
    filt = filt * jnp.exp(-t * deltas)[:, None, None, :]
    fwd, bwd = filt[:, :, 0], filt[:, :, 1]
    k = jnp.concatenate([fwd, jnp.zeros_like(fwd[:1]), bwd[:0:-1]], axis=0)
    k = k / (jnp.sum(jnp.abs(k), axis=0, keepdims=True) + EPS)
    return jnp.fft.rfft(k, axis=0)


def long_conv(z, k_hat, bias):
    l = z.shape[1]
    y = jnp.fft.irfft(jnp.fft.rfft(z, n=2 * l, axis=1) * k_hat, n=2 * l, axis=1)[:, :l]
    return y + bias * z


def hyena_mix(u, conv_w, conv_b, k_hat, bias):
    u = short_conv(u, conv_w, conv_b).astype(F32)
    v, x1, x2 = jnp.split(u, 3, axis=-1)
    bias = bias.astype(F32)
    z = x1 * long_conv(v, k_hat[:, 0], bias[0])
    return x2 * long_conv(z, k_hat[:, 1], bias[1])


def mlstm_prep(q, k, v, gif, conv_w, conv_b, gate_b):
    b, l, _ = k.shape

    def heads(a):
        return a.astype(F32).reshape(b, l, MLSTM_HEADS, MLSTM_DH).transpose(0, 2, 1, 3)
    if q is not None:
        q = heads(jax.nn.silu(short_conv(q, conv_w[0], conv_b[0])))
    k = heads(jax.nn.silu(short_conv(k, conv_w[1], conv_b[1]))) * (MLSTM_DH ** -0.5)
    v = heads(v)
    g = gif.astype(F32).reshape(b, l, N_DIR, 2, MLSTM_HEADS) + gate_b.astype(F32)
    g = jnp.transpose(g, (2, 3, 0, 4, 1))
    return q, k, v, g[:, 0], jax.nn.log_sigmoid(g[:, 1])


def mlstm_zero_state(b):
    return (jnp.zeros((b, MLSTM_HEADS, MLSTM_DH, MLSTM_DH), F32),
            jnp.zeros((b, MLSTM_HEADS, MLSTM_DH), F32),
            jnp.zeros((b, MLSTM_HEADS), F32))


def mlstm_scan(q, k, v, li, lf, state):
    b, h, l, d = k.shape
    nc = l // CHUNK

    def chunked(a):
        return None if a is None else jnp.moveaxis(a.reshape(b, h, nc, CHUNK, *a.shape[3:]), 2, 0)
    mask = jnp.tril(jnp.ones((CHUNK, CHUNK), dtype=bool))

    def step(carry, xs):
        c_st, n_st, m_st = carry
        qc, kc, vc, lic, lfc = xs
        bcum = jnp.cumsum(lfc, axis=-1)
        logw = jnp.where(mask, bcum[..., :, None] - bcum[..., None, :] + lic[..., None, :], -jnp.inf)
        m_pos = jnp.maximum(bcum + m_st[..., None], jnp.max(logw, axis=-1))
        m_next = m_pos[..., -1]
        w_state = jnp.exp(logw[..., -1, :] - m_next[..., None])
        decay = jnp.exp(bcum[..., -1] + m_st - m_next)
        c_next = decay[..., None, None] * c_st + jnp.einsum("bhs,bhsk,bhsv->bhkv", w_state, kc, vc)
        n_next = decay[..., None] * n_st + jnp.einsum("bhs,bhsk->bhk", w_state, kc)
        if qc is None:
            return (c_next, n_next, m_next), None
        w_intra = jnp.exp(logw - m_pos[..., None])
        w_prev = jnp.exp(bcum + m_st[..., None] - m_pos)
        s = jnp.einsum("bhtk,bhsk->bhts", qc, kc) * w_intra
        num = jnp.einsum("bhts,bhsv->bhtv", s, vc) + w_prev[..., None] * jnp.einsum("bhtk,bhkv->bhtv", qc, c_st)
        den = jnp.sum(s, axis=-1) + w_prev * jnp.einsum("bhtk,bhk->bht", qc, n_st)
        out = num / jnp.maximum(jnp.abs(den), jnp.exp(-m_pos))[..., None]
        return (c_next, n_next, m_next), out

    xs = (chunked(q), chunked(k), chunked(v), chunked(li), chunked(lf))
    state, out = lax.scan(step, state, xs)
    if out is not None:
        out = jnp.moveaxis(out, 0, 2).reshape(b, h, l, d)
    return out, state


def gla_prep(q, k, v, a_low, w2, b2):
    b, l, _ = k.shape

    def heads(a, dh):
        return a.astype(F32).reshape(b, l, GLA_HEADS, dh).transpose(0, 2, 1, 3)
    if q is not None:
        q = heads(q, GLA_DK) * (GLA_DK ** -0.5)
    k = heads(k, GLA_DK)
    v = heads(v, GLA_DV)
    a = a_low.astype(F32).reshape(b, l, N_DIR, GLA_RANK)
    la = jax.nn.log_sigmoid(jnp.einsum("bldr,drk->dblk", a, w2.astype(F32)) + b2.astype(F32)[:, None, None, :]) / GLA_TAU
    la = la.reshape(N_DIR, b, l, GLA_HEADS, GLA_DK).transpose(0, 1, 3, 2, 4)
    return q, k, v, la


def gla_zero_state(b):
    return jnp.zeros((b, GLA_HEADS, GLA_DK, GLA_DV), F32)


def gla_scan(q, k, v, la, state):
    b, h, l, dk = k.shape
    nc = l // CHUNK

    def chunked(a):
        return None if a is None else jnp.moveaxis(a.reshape(b, h, nc, CHUNK, *a.shape[3:]), 2, 0)
    mask = jnp.tril(jnp.ones((CHUNK, CHUNK), dtype=bool))[:, :, None]

    def step(s_prev, xs):
        qc, kc, vc, lac = xs
        bc = jnp.cumsum(lac, axis=2)
        b_last = bc[:, :, -1]
        s_next = jnp.exp(b_last)[..., None] * s_prev + jnp.einsum(
            "bhsk,bhsv->bhkv", kc * jnp.exp(b_last[:, :, None] - bc), vc)
        if qc is None:
            return s_next, None
        decay = jnp.exp(jnp.where(mask, bc[:, :, :, None] - bc[:, :, None], -jnp.inf))
        att = jnp.einsum("bhtk,bhsk,bhtsk->bhts", qc, kc, decay)
        out = jnp.einsum("bhts,bhsv->bhtv", att, vc) + jnp.einsum("bhtk,bhkv->bhtv", qc * jnp.exp(bc), s_prev)
        return s_next, out

    state, out = lax.scan(step, state, (chunked(q), chunked(k), chunked(v), chunked(la)))
    if out is not None:
        out = jnp.moveaxis(out, 0, 2).reshape(b, h, l, GLA_DV)
    return out, state


def gla_out(o, g):
    o = o * lax.rsqrt(jnp.mean(o * o, axis=-1, keepdims=True) + EPS)
    return merge_heads(o) * g.astype(F32)


def bidir(scan_fn, q, k, v, gates, states):
    out_f, st_f = scan_fn(q, k, v, *[g[0] for g in gates], states[0])
    out_b, st_b = scan_fn(flip_t(q), flip_t(k), flip_t(v), *[flip_t(g[1]) for g in gates], states[1])
    out = None if q is None else out_f + flip_t(out_b)
    return out, (st_f, st_b)


def combine(z, o_m, o_g, p):
    l = z["a_u"].shape[1]

    def silu(a):
        return jax.nn.silu(a.astype(F32))
    y_a = fourier_mix(z["a_u"], p["fnet_w"]) * silu(z["a_g"])
    y_b = hyena_mix(z["b_u"], p["hy_conv_w"], p["hy_conv_b"], hyena_filter_spectrum(l, p), p["hy_bias"]) * silu(z["b_g"])
    y_c = o_m * jax.nn.sigmoid(z["c_o"].astype(F32)) * silu(z["c_g"])
    y_d = gla_out(o_g, p["gla_norm_g"]) * silu(z["d_g"])
    y = jnp.concatenate([y_a, y_b, y_c, y_d], axis=-1).astype(z["a_u"].dtype)
    return y @ p["w_out"]


def mixer_layer(x, xc, c, c_ctx, p, last):
    b, l, d = x.shape
    rows = l // GRID_W
    mod = jax.nn.silu(c) @ p["ada_w"] + p["ada_b"]
    shift, scale, gate = jnp.split(mod, 3, axis=-1)
    h = rmsnorm(x, p["norm_g"]) * (1 + scale[:, None]) + shift[:, None]
    n_mod = 2 if last else 3
    mod_c = jax.nn.silu(c_ctx) @ p["ada_w"][:, :n_mod * d] + p["ada_b"][:n_mod * d]
    hc = rmsnorm(xc, p["norm_g"]) * (1 + mod_c[d:2 * d]) + mod_c[:d]
    z = project(h, p["w_in"], None)
    zc = project(hc, p["w_in"], CTX_STATE_NAMES if last else None)
    ctx_q_m = None if last else zc["c_q"]
    ctx_q_g = None if last else zc["d_q"]

    mc = mlstm_prep(ctx_q_m, zc["c_k"], zc["c_v"], zc["c_if"], p["ml_conv_w"], p["ml_conv_b"], p["ml_gate_b"])
    ctx_m, m_states = bidir(mlstm_scan, mc[0], mc[1], mc[2], mc[3:], (mlstm_zero_state(b), mlstm_zero_state(b)))
    ml = mlstm_prep(to_col_major(z["c_q"], rows), to_col_major(z["c_k"], rows), to_col_major(z["c_v"], rows),
                    to_col_major(z["c_if"], rows), p["ml_conv_w"], p["ml_conv_b"], p["ml_gate_b"])
    lat_m, _ = bidir(mlstm_scan, ml[0], ml[1], ml[2], ml[3:], m_states)
    lat_m = from_col_major(merge_heads(lat_m), rows)

    gc = gla_prep(ctx_q_g, zc["d_k"], zc["d_v"], zc["d_a"], p["gla_w2"], p["gla_b2"])
    ctx_g, g_states = bidir(gla_scan, gc[0], gc[1], gc[2], gc[3:], (gla_zero_state(b), gla_zero_state(b)))
    gl = gla_prep(z["d_q"], z["d_k"], z["d_v"], z["d_a"], p["gla_w2"], p["gla_b2"])
    lat_g, _ = bidir(gla_scan, gl[0], gl[1], gl[2], gl[3:], g_states)

    x = x + gate[:, None] * combine(z, lat_m, lat_g, p)
    if not last:
        xc = xc + mod_c[2 * d:] * combine(zc, merge_heads(ctx_m), ctx_g, p)
    return x, xc


def setup_inputs(seed: int = 0) -> dict:
    key = jax.random.key(seed)
    ks = jax.random.split(key, 32)

    def nrm(i, shape, s):
        return jax.random.normal(ks[i], shape, F32) * s
    D, W, L = D_MODEL, GROUP_W, DEPTH
    f_bias = jnp.linspace(3.0, 6.0, MLSTM_HEADS, dtype=F32)
    ml_gate_b = jnp.concatenate([nrm(20, (L, N_DIR, 1, MLSTM_HEADS), 0.1),
                                 f_bias + nrm(21, (L, N_DIR, 1, MLSTM_HEADS), 0.1)], axis=2)
    return {
        "x": nrm(0, (BATCH, SEQ, D), 1.0),
        "c": nrm(1, (BATCH, D), 1.0),
        "ctx": nrm(2, (BATCH, CTX_LEN, D), 1.0),
        "c_ctx": nrm(3, (D,), 1.0),
        "ada_w": nrm(4, (L, D, 3 * D), 0.5 * D ** -0.5),
        "ada_b": nrm(5, (L, 3 * D), 0.02),
        "norm_g": 1.0 + nrm(6, (L, D), 0.02),
        "w_in": nrm(7, (L, D, PROJ_W), D ** -0.5),
        "fnet_w": nrm(8, (L, W, W), W ** -0.5),
        "hy_conv_w": nrm(9, (L, SHORT_CONV, 3 * W), SHORT_CONV ** -0.5),
        "hy_conv_b": nrm(10, (L, 3 * W), 0.02),
        "hy_f_w1": nrm(11, (L, HYENA_EMB, HYENA_HID), HYENA_EMB ** -0.5),
        "hy_f_b1": nrm(12, (L, HYENA_HID), 0.02),
        "hy_f_w2": nrm(13, (L, HYENA_HID, HYENA_HID), HYENA_HID ** -0.5),
        "hy_f_b2": nrm(14, (L, HYENA_HID), 0.02),
        "hy_f_w3": nrm(15, (L, HYENA_HID, HYENA_ORDER * N_DIR * W), HYENA_HID ** -0.5),
        "hy_f_freq": 1.0 + nrm(16, (L, 2, HYENA_HID), 0.02),
        "hy_bias": nrm(17, (L, HYENA_ORDER, W), 0.1),
        "ml_conv_w": nrm(18, (L, 2, SHORT_CONV, W), SHORT_CONV ** -0.5),
        "ml_conv_b": nrm(19, (L, 2, W), 0.02),
        "ml_gate_b": ml_gate_b,
        "gla_w2": nrm(22, (L, N_DIR, GLA_RANK, GLA_HEADS * GLA_DK), GLA_RANK ** -0.5),
        "gla_b2": nrm(23, (L, N_DIR, GLA_HEADS * GLA_DK), 0.02),
        "gla_norm_g": 1.0 + nrm(24, (L, W), 0.02),
        "w_out": nrm(25, (L, D, D), D ** -0.5),
        "final_g": 1.0 + nrm(26, (D,), 0.02),
    }


def reference(x, c, ctx, c_ctx, ada_w, ada_b, norm_g, w_in, fnet_w, hy_conv_w, hy_conv_b, hy_f_w1, hy_f_b1,
              hy_f_w2, hy_f_b2, hy_f_w3, hy_f_freq, hy_bias, ml_conv_w, ml_conv_b, ml_gate_b, gla_w2, gla_b2,
              gla_norm_g, w_out, final_g):
    xc = ctx
    for i in range(DEPTH):
        p = {
            "ada_w": ada_w[i], "ada_b": ada_b[i], "norm_g": norm_g[i], "w_in": w_in[i], "fnet_w": fnet_w[i],
            "hy_conv_w": hy_conv_w[i], "hy_conv_b": hy_conv_b[i], "hy_f_w1": hy_f_w1[i], "hy_f_b1": hy_f_b1[i],
            "hy_f_w2": hy_f_w2[i], "hy_f_b2": hy_f_b2[i], "hy_f_w3": hy_f_w3[i], "hy_f_freq": hy_f_freq[i],
            "hy_bias": hy_bias[i], "ml_conv_w": ml_conv_w[i], "ml_conv_b": ml_conv_b[i], "ml_gate_b": ml_gate_b[i],
            "gla_w2": gla_w2[i], "gla_b2": gla_b2[i], "gla_norm_g": gla_norm_g[i], "w_out": w_out[i],
        }
        x, xc = mixer_layer(x, xc, c, c_ctx, p, i == DEPTH - 1)
    return rmsnorm(x, final_g)
```

```cpp
#include <hip/hip_runtime.h>
#include <stdio.h>
#include <stdint.h>
#include <math.h>

namespace pg8 {
#define PG8_LAS __attribute__((address_space(3)))
typedef unsigned short bf16_t;
typedef short bf16x8 __attribute__((ext_vector_type(8)));
typedef float f32x4 __attribute__((ext_vector_type(4)));
typedef unsigned u32x4 __attribute__((ext_vector_type(4)));
constexpr int BM = 256, BK = 64, HALF = 128, HTB = HALF * BK * 2  , STAGE_BYTES = 8 * HTB, NXCD = 8, WGM = 8;

__host__ __device__ __forceinline__ int lds_byte(int r, int c) { const int st = (r >> 4) * 2 + (c >> 5), rr = r & 15, cc = c & 31, ob = rr * 64 + cc * 2; return st * 1024 + (ob ^ (((ob >> 9) & 1) << 5)); }
__host__ __device__ __forceinline__ void stage_rc(int b, int& R, int& C) { const int st = b / 1024, sb = b % 1024, swz = sb ^ (((sb >> 9) & 1) << 5); R = (st >> 1) * 16 + swz / 64; C = (st & 1) * 32 + (swz % 64) / 2; }
__host__ __device__ __forceinline__ int perm32(int rho) { const int n = rho >> 4, i = rho & 15; return 8 * (i >> 2) + 4 * n + (i & 3); }

struct Unit { int pm, pn; };
struct Gemm { const bf16_t* A; const bf16_t* Bt; int M, N, K; };

struct StaticOrder {
    int nM, nN, nwg, G, c;
    __host__ __device__ void init(int M, int N, int G_, int c_) { nM = M / BM; nN = N / BM; nwg = nM * nN; G = G_; c = c_; }
    __host__ __device__ bool next(int i, Unit& u) const {
        const long L = (long)i * G + c; if (L >= nwg) return false;
        int wgid = (int)L; { const int q = nwg / NXCD, r = nwg % NXCD, xcd = wgid % NXCD, off = wgid / NXCD; wgid = (xcd < r ? xcd * (q + 1) : r * (q + 1) + (xcd - r) * q) + off; }
        const int nig = WGM * nN, gid = wgid / nig, fm = gid * WGM, gsz = (nM - fm) < WGM ? (nM - fm) : WGM;
        u.pm = fm + ((wgid % nig) % gsz); u.pn = (wgid % nig) / gsz; return true;
    }
    __device__ __forceinline__ void a_ready(const Unit&) const {}
    __device__ __forceinline__ void done(const Unit&) const {}
};

__device__ __forceinline__ unsigned cvt_pk_bf16(float lo, float hi) { unsigned r; asm volatile("v_cvt_pk_bf16_f32 %0, %1, %2" : "=v"(r) : "v"(lo), "v"(hi)); return r; }

template <class Epi, class Sched, bool STAMP = false>
__device__ __forceinline__ void gemm_phase(PG8_LAS unsigned char* lds, const Gemm g, const Sched& S, const Epi& E, unsigned long long* stamps) {
    const int tid = threadIdx.x, wid = __builtin_amdgcn_readfirstlane(tid >> 6), lane = tid & 63, wr = wid >> 2, wc = wid & 3, fr = lane & 15, fq = lane >> 4;
    const int K = g.K, nt = K / BK;
    int ts_lo = 0, ts_hi = 0, nts = 0; const unsigned long long rt_entry = STAMP ? (unsigned long long)wall_clock64() : 0ull;
#define PG8_STAMP() do { if (STAMP && wid == 0 && nts < 64) { const unsigned long long _c = (unsigned long long)clock64(); \
        ts_lo = (lane == nts) ? (int)(unsigned)_c : ts_lo; ts_hi = (lane == nts) ? (int)(unsigned)(_c >> 32) : ts_hi; ++nts; } } while (0)
    PG8_STAMP();
    unsigned voffA[2], voffB[2];
#pragma unroll
    for (int i = 0; i < 2; ++i) { int R, C; stage_rc(tid * 16 + i * 8192, R, C); const int Rb = Epi::PERM ? ((R & ~31) + perm32(R & 31)) : R;
        voffA[i] = (unsigned)(R * K + C) * 2u; voffB[i] = (unsigned)(Rb * K + C) * 2u; }
    const size_t kstep = (size_t)(BK * 2);
    const size_t hstep = (size_t)HALF * K * 2;
    const size_t tstep = 2 * hstep;
    const unsigned ldsw = (unsigned)wid * 1024u;
    const int aoff = lds_byte(wr * 64 + fr, fq * 8), boff = lds_byte(wc * 32 + fr, fq * 8);
#define PG8_SA(b, h) (((b) * 2 + (h)) * HTB)
#define PG8_SB(b, h) ((4 + (b) * 2 + (h)) * HTB)
#define PG8_STAGE(bufoff, gbase, voff) do { _Pragma("unroll") for (int _i = 0; _i < 2; ++_i) \
        __builtin_amdgcn_global_load_lds((const unsigned*)((const char*)(gbase) + (voff)[_i]), (PG8_LAS unsigned*)(lds + (bufoff) + ldsw + _i * 8192), 16, 0, 0); } while (0)
#define PG8_LDA(dst, b, h) do { _Pragma("unroll") for (int m = 0; m < 4; ++m) _Pragma("unroll") for (int k = 0; k < 2; ++k) dst[m][k] = *(const PG8_LAS bf16x8*)(lds + PG8_SA(b, h) + aoff + m * 2048 + k * 1024); } while (0)
#define PG8_LDB(dst, b, h) do { _Pragma("unroll") for (int n = 0; n < 2; ++n) _Pragma("unroll") for (int k = 0; k < 2; ++k) dst[n][k] = *(const PG8_LAS bf16x8*)(lds + PG8_SB(b, h) + boff + n * 2048 + k * 1024); } while (0)
#define PG8_MMA(ai, bj, At, Bt) do { __builtin_amdgcn_s_setprio(1); _Pragma("unroll") for (int m = 0; m < 4; ++m) _Pragma("unroll") for (int n = 0; n < 2; ++n) _Pragma("unroll") for (int k = 0; k < 2; ++k) \
        acc[ai][bj][m][n] = __builtin_amdgcn_mfma_f32_16x16x32_bf16(Bt[n][k], At[m][k], acc[ai][bj][m][n], 0, 0, 0); __builtin_amdgcn_s_setprio(0); } while (0)
#define PG8_WAIT_V(n) asm volatile("s_waitcnt vmcnt(" #n ")" ::: "memory")
#define PG8_WAIT_L(n) asm volatile("s_waitcnt lgkmcnt(" #n ")" ::: "memory")
#define PG8_BAR __builtin_amdgcn_s_barrier()
#define PG8_SCHED __builtin_amdgcn_sched_barrier(0)
    Unit cur, nxt; int ui = 0;
    if (!S.next(0, cur)) return;
    f32x4 acc[2][2][4][2];
#pragma unroll
    for (int a = 0; a < 2; ++a)
#pragma unroll
        for (int b = 0; b < 2; ++b)
#pragma unroll
            for (int m = 0; m < 4; ++m)
#pragma unroll
                for (int n = 0; n < 2; ++n) acc[a][b][m][n] = (f32x4){0.f, 0.f, 0.f, 0.f};
    bf16x8 At[4][2], B0[2][2], B1[2][2];
    const char* cA = (const char*)g.A + (size_t)cur.pm * tstep; const char* cB = (const char*)g.Bt + (size_t)cur.pn * tstep;
    S.a_ready(cur);
    PG8_STAGE(PG8_SB(0, 0), cB, voffB); PG8_STAGE(PG8_SA(0, 0), cA, voffA); PG8_STAGE(PG8_SB(0, 1), cB + hstep, voffB); PG8_STAGE(PG8_SA(0, 1), cA + hstep, voffA);
    if (wr == 1) PG8_BAR;
    PG8_WAIT_V(4); PG8_BAR;
    PG8_STAGE(PG8_SB(1, 0), cB + kstep, voffB); PG8_STAGE(PG8_SA(1, 0), cA + kstep, voffA); PG8_STAGE(PG8_SB(1, 1), cB + hstep + kstep, voffB);
    PG8_WAIT_V(6); PG8_BAR;
    PG8_STAMP();
    for (;;) {
        const bool has_next = S.next(ui + 1, nxt);
        const char* nA = has_next ? (const char*)g.A + (size_t)nxt.pm * tstep : cA; const char* nB = has_next ? (const char*)g.Bt + (size_t)nxt.pn * tstep : cB;
        for (int t = 0; t < nt; t += 2) {
            const bool last = (t == nt - 2);
            const char* a1 = cA + (size_t)(t + 1) * kstep;
            const char* a2 = last ? nA : cA + (size_t)(t + 2) * kstep; const char* b2 = last ? nB : cB + (size_t)(t + 2) * kstep;
            const char* a3 = a2 + kstep; const char* b3 = b2 + kstep;
            if (last && has_next) S.a_ready(nxt);
            PG8_LDB(B0, 0, 0); PG8_SCHED; PG8_LDA(At, 0, 0); PG8_STAGE(PG8_SA(1, 1), a1 + hstep, voffA);
            PG8_WAIT_L(8); PG8_BAR; PG8_WAIT_L(0); PG8_MMA(0, 0, At, B0); PG8_BAR; PG8_SCHED;
            PG8_LDB(B1, 0, 1); PG8_STAGE(PG8_SB(0, 0), b2, voffB);
            PG8_BAR; PG8_WAIT_L(0); PG8_MMA(0, 1, At, B1); PG8_BAR;
            PG8_LDA(At, 0, 1); PG8_STAGE(PG8_SA(0, 0), a2, voffA);
            PG8_BAR; PG8_WAIT_L(0); PG8_MMA(1, 0, At, B0); PG8_BAR; PG8_SCHED;
            PG8_STAGE(PG8_SB(0, 1), b2 + hstep, voffB);
            PG8_WAIT_V(6); PG8_BAR; PG8_MMA(1, 1, At, B1); PG8_BAR;
            PG8_LDB(B0, 1, 0); PG8_SCHED; PG8_LDA(At, 1, 0); PG8_STAGE(PG8_SA(0, 1), a2 + hstep, voffA);
            PG8_WAIT_L(8); PG8_BAR; PG8_WAIT_L(0); PG8_MMA(0, 0, At, B0); PG8_BAR; PG8_SCHED;
            PG8_LDB(B1, 1, 1); PG8_STAGE(PG8_SB(1, 0), b3, voffB);
            PG8_BAR; PG8_WAIT_L(0); PG8_MMA(0, 1, At, B1); PG8_BAR;
            PG8_LDA(At, 1, 1); PG8_STAGE(PG8_SA(1, 0), a3, voffA);
            PG8_BAR; PG8_WAIT_L(0); PG8_MMA(1, 0, At, B0); PG8_BAR; PG8_SCHED;
            PG8_STAGE(PG8_SB(1, 1), b3 + hstep, voffB);
            PG8_WAIT_V(6); PG8_BAR; PG8_MMA(1, 1, At, B1); PG8_BAR;
        }
        PG8_STAMP();
        if constexpr (!Epi::AFTER_DRAIN) { E(acc, cur, wr, wc, fr, fq); S.done(cur); }
        PG8_STAMP();
        if (!has_next) break;
#pragma unroll
        for (int a = 0; a < 2; ++a)
#pragma unroll
            for (int b = 0; b < 2; ++b)
#pragma unroll
                for (int m = 0; m < 4; ++m)
#pragma unroll
                    for (int n = 0; n < 2; ++n) acc[a][b][m][n] = (f32x4){0.f, 0.f, 0.f, 0.f};
        cur = nxt; cA = nA; cB = nB; ++ui;
    }
    PG8_WAIT_V(0);
    if (wr == 0) PG8_BAR;
    PG8_BAR;
    if constexpr (Epi::AFTER_DRAIN) { E.fused(acc, cur, wr, wc, fr, fq, lds, wid, lane); S.done(cur); }
    PG8_STAMP();
    if (STAMP && wid == 0) { stamps[lane] = lane < nts ? (((unsigned long long)(unsigned)ts_hi << 32) | (unsigned)ts_lo) : 0ull;
        if (lane == 62) stamps[62] = rt_entry; if (lane == 63) stamps[63] = (unsigned long long)wall_clock64(); }
#undef PG8_STAMP
#undef PG8_SA
#undef PG8_SB
#undef PG8_STAGE
#undef PG8_LDA
#undef PG8_LDB
#undef PG8_MMA
#undef PG8_WAIT_V
#undef PG8_WAIT_L
#undef PG8_BAR
#undef PG8_SCHED
}
}

typedef unsigned short bf16_t;
typedef float f32x4 __attribute__((ext_vector_type(4)));
typedef unsigned u32x4 __attribute__((ext_vector_type(4)));
typedef unsigned u32x2 __attribute__((ext_vector_type(2)));
#define LAS __attribute__((address_space(3)))

constexpr int D = 4096, NB = 2, SEQ = 4096, CTXL = 256, GW = 1024;
constexpr int MLAT = NB * SEQ, MCTX = NB * CTXL, MROWS = MLAT + MCTX;
constexpr int PROJ_W = 14384, NP = 14592;
constexpr int ZC_AU = 0, ZC_AG = 1024, ZC_BU = 2048, ZC_BG = 5120, ZC_CQ = 6144, ZC_CK = 7168, ZC_CV = 8192, ZC_CO = 9216, ZC_CG = 10240,
              ZC_DQ = 11264, ZC_DK = 11776, ZC_DV = 12288, ZC_DG = 13312, ZC_GATE = 14336;
constexpr int NTN_IN = NP / 256;
constexpr float EPS = 1e-6f;
constexpr int ADA_KS = 32;
constexpr int SEQP = CTXL + SEQ;

__device__ __forceinline__ float bf2f(bf16_t b) { return __uint_as_float(((unsigned)b) << 16); }
__device__ __forceinline__ bf16_t f2bf(float f) { unsigned u = __float_as_uint(f); u += 0x7FFFu + ((u >> 16) & 1u); return (bf16_t)(u >> 16); }
__device__ __forceinline__ float silu_f(float x) { return x / (1.f + expf(-x)); }
__device__ __forceinline__ float sigmoid_f(float x) { return 1.f / (1.f + expf(-x)); }
__device__ __forceinline__ float logsigmoid_f(float x) { return fminf(x, 0.f) - log1pf(expf(-fabsf(x))); }

__device__ __forceinline__ int win_colmap(int n) {
    if (n < 11264) return n;
    if (n < 14336) return n + 16;
    if (n < 14352) return n - 14336 + 11264;
    if (n < 14384) return n;
    return -1;
}
__global__ __launch_bounds__(256) void k_transpose(const float* __restrict__ src, bf16_t* __restrict__ dst, int K, int srcN, int mode) {
    __shared__ float tile[64][65];
    const int n0 = blockIdx.x * 64, k0 = blockIdx.y * 64;
    for (int i = threadIdx.x; i < 4096; i += 256) {
        const int kk = i >> 6, nn = i & 63; const int sn = mode ? win_colmap(n0 + nn) : (n0 + nn);
        tile[kk][nn] = sn >= 0 ? src[(size_t)(k0 + kk) * srcN + sn] : 0.f;
    }
    __syncthreads();
    for (int i = threadIdx.x; i < 4096; i += 256) {
        const int nn = i >> 6, kk = i & 63;
        dst[(size_t)(n0 + nn) * K + k0 + kk] = f2bf(tile[kk][nn]);
    }
}

__global__ __launch_bounds__(256) void k_ada_partial(const float* __restrict__ c, const float* __restrict__ c_ctx, const float* __restrict__ ada_w, float* __restrict__ part) {
    const int layer = blockIdx.z, ks = blockIdx.y, cb = blockIdx.x, tid = threadIdx.x;
    constexpr int KC = D / ADA_KS;
    __shared__ float s[3][KC];
    const int k0 = ks * KC;
    for (int i = tid; i < 3 * KC; i += 256) { const int v = i / KC, kk = i % KC; const float x = v < 2 ? c[v * D + k0 + kk] : c_ctx[k0 + kk]; s[v][kk] = silu_f(x); }
    __syncthreads();
    const float* w = ada_w + (size_t)layer * D * 3 * D + (size_t)k0 * 3 * D + cb * 1024 + tid * 4;
    f32x4 a0 = {0, 0, 0, 0}, a1 = {0, 0, 0, 0}, a2 = {0, 0, 0, 0};
#pragma unroll 8
    for (int kk = 0; kk < KC; ++kk) { const f32x4 wv = *(const f32x4*)(w + (size_t)kk * 3 * D); a0 += s[0][kk] * wv; a1 += s[1][kk] * wv; a2 += s[2][kk] * wv; }
    float* p = part + ((size_t)(layer * ADA_KS + ks) * 3) * 3 * D + cb * 1024 + tid * 4;
    *(f32x4*)(p) = a0; *(f32x4*)(p + 3 * D) = a1; *(f32x4*)(p + 2 * 3 * D) = a2;
}
__global__ __launch_bounds__(256) void k_mod_final(const float* __restrict__ part, const float* __restrict__ ada_b, float* __restrict__ mod) {
    const int i = blockIdx.x * 256 + threadIdx.x; const int n = i % (3 * D), v = (i / (3 * D)) % 3, layer = i / (9 * D);
    float a = ada_b[layer * 3 * D + n];
    for (int ks = 0; ks < ADA_KS; ++ks) a += part[((size_t)(layer * ADA_KS + ks) * 3 + v) * 3 * D + n];
    mod[i] = a;
}

__device__ __forceinline__ float block_sum_256(float v, float* red) {
    for (int o = 32; o > 0; o >>= 1) v += __shfl_xor(v, o);
    const int w = threadIdx.x >> 6;
    __syncthreads();
    if ((threadIdx.x & 63) == 0) red[w] = v;
    __syncthreads();
    return red[0] + red[1] + red[2] + red[3];
}
__global__ __launch_bounds__(256) void k_norm_mod(const float* __restrict__ xlat, const float* __restrict__ xctx, const float* __restrict__ g, const float* __restrict__ mod, bf16_t* __restrict__ H) {
    __shared__ float red[4];
    const int r = blockIdx.x, tid = threadIdx.x;
    const float* xr = r < MLAT ? xlat + (size_t)r * D : xctx + (size_t)(r - MLAT) * D;
    const int v = r < MLAT ? r / SEQ : 2;
    const float* shift = mod + v * 3 * D; const float* scale = shift + D;
    f32x4 x[4]; float ss = 0.f;
#pragma unroll
    for (int i = 0; i < 4; ++i) { x[i] = *(const f32x4*)(xr + i * 1024 + tid * 4); ss += x[i][0] * x[i][0] + x[i][1] * x[i][1] + x[i][2] * x[i][2] + x[i][3] * x[i][3]; }
    ss = block_sum_256(ss, red);
    const float rs = rsqrtf(ss * (1.f / D) + EPS);
#pragma unroll
    for (int i = 0; i < 4; ++i) {
        const int c = i * 1024 + tid * 4;
        const f32x4 gg = *(const f32x4*)(g + c), sc = *(const f32x4*)(scale + c), sh = *(const f32x4*)(shift + c);
        f32x4 y = x[i] * rs * gg * (1.f + sc) + sh;
        u32x2 o; o.x = f2bf(y[0]) | ((unsigned)f2bf(y[1]) << 16); o.y = f2bf(y[2]) | ((unsigned)f2bf(y[3]) << 16);
        *(u32x2*)(H + (size_t)r * D + c) = o;
    }
}
__global__ __launch_bounds__(256) void k_final_norm(const float* __restrict__ x, const float* __restrict__ g, float* __restrict__ out) {
    __shared__ float red[4];
    const int r = blockIdx.x, tid = threadIdx.x;
    const float* xr = x + (size_t)r * D;
    f32x4 xv[4]; float ss = 0.f;
#pragma unroll
    for (int i = 0; i < 4; ++i) { xv[i] = *(const f32x4*)(xr + i * 1024 + tid * 4); ss += xv[i][0] * xv[i][0] + xv[i][1] * xv[i][1] + xv[i][2] * xv[i][2] + xv[i][3] * xv[i][3]; }
    ss = block_sum_256(ss, red);
    const float rs = rsqrtf(ss * (1.f / D) + EPS);
#pragma unroll
    for (int i = 0; i < 4; ++i) { const int c = i * 1024 + tid * 4; *(f32x4*)(out + (size_t)r * D + c) = xv[i] * rs * *(const f32x4*)(g + c); }
}

struct EpiInProj {
    static constexpr bool PERM = true, AFTER_DRAIN = false;
    bf16_t* Z; float* ZG;
    __device__ __forceinline__ void operator()(const f32x4 (&acc)[2][2][4][2], const pg8::Unit& u, int wr, int wc, int fr, int fq) const {
        const int row0 = u.pm * 256 + wr * 64 + fr;
        if (u.pn < NTN_IN - 1) {
            const int col0 = u.pn * 256 + wc * 32 + 8 * fq;
#pragma unroll
            for (int ai = 0; ai < 2; ++ai)
#pragma unroll
                for (int m = 0; m < 4; ++m) { bf16_t* rowp = Z + (size_t)(row0 + ai * 128 + m * 16) * NP + col0;
#pragma unroll
                    for (int bj = 0; bj < 2; ++bj) { const f32x4 v0 = acc[ai][bj][m][0], v1 = acc[ai][bj][m][1];
                        u32x4 w; w.x = pg8::cvt_pk_bf16(v0[0], v0[1]); w.y = pg8::cvt_pk_bf16(v0[2], v0[3]); w.z = pg8::cvt_pk_bf16(v1[0], v1[1]); w.w = pg8::cvt_pk_bf16(v1[2], v1[3]);
                        *(u32x4*)(rowp + bj * 128) = w; } }
        } else {
            const int col0 = wc * 32 + 8 * fq;
#pragma unroll
            for (int ai = 0; ai < 2; ++ai)
#pragma unroll
                for (int m = 0; m < 4; ++m) { float* rowp = ZG + (size_t)(row0 + ai * 128 + m * 16) * 256 + col0;
#pragma unroll
                    for (int bj = 0; bj < 2; ++bj) { *(f32x4*)(rowp + bj * 128) = acc[ai][bj][m][0]; *(f32x4*)(rowp + bj * 128 + 4) = acc[ai][bj][m][1]; } }
        }
    }
};
struct EpiOut {
    static constexpr bool PERM = true, AFTER_DRAIN = false;
    const float* xlat; const float* xctx; const float* mod; float* xo;
    __device__ __forceinline__ void operator()(const f32x4 (&acc)[2][2][4][2], const pg8::Unit& u, int wr, int wc, int fr, int fq) const {
        const int row0 = u.pm * 256 + wr * 64 + fr, col0 = u.pn * 256 + wc * 32 + 8 * fq;
#pragma unroll
        for (int ai = 0; ai < 2; ++ai)
#pragma unroll
            for (int m = 0; m < 4; ++m) { const int r = row0 + ai * 128 + m * 16; const int v = r < MLAT ? (r >> 12) : 2;
                const float* xin = r < MLAT ? xlat + (size_t)r * D : xctx + (size_t)(r - MLAT) * D; const float* gate = mod + v * 3 * D + 2 * D;
#pragma unroll
                for (int bj = 0; bj < 2; ++bj)
#pragma unroll
                    for (int n = 0; n < 2; ++n) { const int c = col0 + bj * 128 + 4 * n;
                        const f32x4 xi = *(const f32x4*)(xin + c), g4 = *(const f32x4*)(gate + c);
                        *(f32x4*)(xo + (size_t)r * D + c) = xi + g4 * acc[ai][bj][m][n]; } }
    }
};
struct EpiFnet {
    static constexpr bool PERM = true, AFTER_DRAIN = false;
    const bf16_t* Z; bf16_t* ycat;
    __device__ __forceinline__ void operator()(const f32x4 (&acc)[2][2][4][2], const pg8::Unit& u, int wr, int wc, int fr, int fq) const {
        const int row0 = u.pm * 256 + wr * 64 + fr, col0 = u.pn * 256 + wc * 32 + 8 * fq;
#pragma unroll
        for (int ai = 0; ai < 2; ++ai)
#pragma unroll
            for (int m = 0; m < 4; ++m) { const int r = row0 + ai * 128 + m * 16;
#pragma unroll
                for (int bj = 0; bj < 2; ++bj) { const int c = col0 + bj * 128;
                    const u32x4 gz = *(const u32x4*)(Z + (size_t)r * NP + ZC_AG + c);
                    float gv[8]; gv[0] = __uint_as_float(gz.x << 16); gv[1] = __uint_as_float(gz.x & 0xffff0000u); gv[2] = __uint_as_float(gz.y << 16); gv[3] = __uint_as_float(gz.y & 0xffff0000u);
                    gv[4] = __uint_as_float(gz.z << 16); gv[5] = __uint_as_float(gz.z & 0xffff0000u); gv[6] = __uint_as_float(gz.w << 16); gv[7] = __uint_as_float(gz.w & 0xffff0000u);
                    const f32x4 v0 = acc[ai][bj][m][0], v1 = acc[ai][bj][m][1];
                    u32x4 w; w.x = pg8::cvt_pk_bf16(v0[0] * silu_f(gv[0]), v0[1] * silu_f(gv[1])); w.y = pg8::cvt_pk_bf16(v0[2] * silu_f(gv[2]), v0[3] * silu_f(gv[3]));
                    w.z = pg8::cvt_pk_bf16(v1[0] * silu_f(gv[4]), v1[1] * silu_f(gv[5])); w.w = pg8::cvt_pk_bf16(v1[2] * silu_f(gv[6]), v1[3] * silu_f(gv[7]));
                    *(u32x4*)(ycat + (size_t)r * D + c) = w; } }
    }
};
template <class Epi> __global__ __launch_bounds__(512, 2) void k_gemm(pg8::Gemm g, Epi E) {
    extern __shared__ __attribute__((aligned(16))) unsigned char shm[];
    pg8::StaticOrder S; S.init(g.M, g.N, (int)gridDim.x, (int)blockIdx.x);
    pg8::gemm_phase<Epi, pg8::StaticOrder, false>((PG8_LAS unsigned char*)shm, g, S, E, nullptr);
}

__global__ __launch_bounds__(256) void k_chdft(const bf16_t* __restrict__ Z, float* __restrict__ uc, float* __restrict__ us) {
    __shared__ float u[1024], cs[256], sn[256];
    const int r = blockIdx.x, tid = threadIdx.x;
    for (int i = tid; i < 1024; i += 256) u[i] = bf2f(Z[(size_t)r * NP + ZC_AU + i]);
    { float s, c; sincospif(2.0f * tid / 256.0f, &s, &c); cs[tid] = c; sn[tid] = s; }
    __syncthreads();
    for (int g = 0; g < 4; ++g) {
        float ac = 0.f, as = 0.f;
        for (int c = 0; c < 256; ++c) { const int idx = (c * tid) & 255; const float x = u[g * 256 + c]; ac += x * cs[idx]; as += x * sn[idx]; }
        uc[(size_t)r * 1024 + g * 256 + tid] = ac; us[(size_t)r * 1024 + g * 256 + tid] = as;
    }
}
__global__ __launch_bounds__(256) void k_seqdft(const float* __restrict__ uc, const float* __restrict__ us, bf16_t* __restrict__ YA, int rowbase, int L, float scale) {
    __shared__ float cs[4096], sn[4096];
    __shared__ float tuc[32][64], tus[32][64];
    const int tid = threadIdx.x, tc = tid & 15, tl = tid >> 4;
    const int c0 = blockIdx.x * 64, lp0 = blockIdx.y * 64, b = blockIdx.z;
    for (int i = tid; i < L; i += 256) { float s, c; sincospif(2.0f * (float)i / (float)L, &s, &c); cs[i] = c; sn[i] = s; }
    float acc[4][4];
#pragma unroll
    for (int i = 0; i < 4; ++i)
#pragma unroll
        for (int j = 0; j < 4; ++j) acc[i][j] = 0.f;
    const size_t rb = (size_t)rowbase + (size_t)b * L;
    for (int l0 = 0; l0 < L; l0 += 32) {
        __syncthreads();
        for (int i = tid; i < 2048; i += 256) { const int ll = i >> 6, cc = i & 63; tuc[ll][cc] = uc[(rb + l0 + ll) * 1024 + c0 + cc]; tus[ll][cc] = us[(rb + l0 + ll) * 1024 + c0 + cc]; }
        __syncthreads();
        for (int ll = 0; ll < 32; ++ll) {
            const int l = l0 + ll;
            const f32x4 a = *(const f32x4*)&tuc[ll][tc * 4], bb = *(const f32x4*)&tus[ll][tc * 4];
#pragma unroll
            for (int i = 0; i < 4; ++i) { const int idx = (l * (lp0 + tl * 4 + i)) & (L - 1); const float co = cs[idx], si = sn[idx];
#pragma unroll
                for (int j = 0; j < 4; ++j) acc[i][j] += co * a[j] - si * bb[j]; }
        }
    }
#pragma unroll
    for (int i = 0; i < 4; ++i)
#pragma unroll
        for (int j = 0; j < 4; ++j) YA[(rb + lp0 + tl * 4 + i) * 1024 + c0 + tc * 4 + j] = f2bf(acc[i][j] * scale);
}

constexpr float HY_FAST = -15.350567286626973f, HY_SLOW = -3.0701134573253946f;
__global__ __launch_bounds__(64) void k_hy_hid(const float* __restrict__ w1, const float* __restrict__ b1, const float* __restrict__ w2, const float* __restrict__ b2, const float* __restrict__ freq, float* __restrict__ hid2, int L) {
    __shared__ float feats[33], h1[64];
    const int pos = blockIdx.x, j = threadIdx.x;
    if (j < 33) {
        if (j == 0) feats[0] = (float)((double)pos / (double)(L - 1));
        else { const int i = (j - 1) & 15; const double band = 1e-4 + (double)i * ((15.0 - 1e-4) / 15.0); const double ang = (2.0 * 3.14159265358979323846 / (double)L) * (double)pos * band;
            feats[j] = j <= 16 ? (float)cos(ang) : (float)(-sin(ang)); }
    }
    __syncthreads();
    float a = b1[j];
    for (int i = 0; i < 33; ++i) a += feats[i] * w1[i * 64 + j];
    h1[j] = sinf(freq[j] * a);
    __syncthreads();
    float a2 = b2[j];
    for (int i = 0; i < 64; ++i) a2 += h1[i] * w2[i * 64 + j];
    hid2[pos * 64 + j] = sinf(freq[64 + j] * a2);
}
__global__ __launch_bounds__(256) void k_hy_filt(const float* __restrict__ hid2, const float* __restrict__ w3, float* __restrict__ K2, int L) {
    __shared__ float h[64];
    const int pos = blockIdx.x, od = blockIdx.y, o = od >> 1, dir = od & 1, tid = threadIdx.x;
    if (tid < 64) h[tid] = hid2[pos * 64 + tid];
    __syncthreads();
    const float t = (float)((double)pos / (double)(L - 1));
    for (int cc = 0; cc < 4; ++cc) {
        const int c = tid + cc * 256;
        float a = 0.f;
        for (int i = 0; i < 64; ++i) a += h[i] * w3[i * 4096 + od * 1024 + c];
        const float delta = fabsf(HY_SLOW + (HY_FAST - HY_SLOW) * ((float)c / 1023.0f));
        const float val = a * expf(-t * delta);
        if (dir == 0) K2[((size_t)o * 2 * L + pos) * 1024 + c] = val;
        else { if (pos >= 1) K2[((size_t)o * 2 * L + 2 * L - pos) * 1024 + c] = val; else K2[((size_t)o * 2 * L + L) * 1024 + c] = 0.f; }
    }
}
__global__ __launch_bounds__(256) void k_hy_norm(const float* __restrict__ K2, float* __restrict__ np, int L) {
    const int c = blockIdx.x * 256 + threadIdx.x, o = blockIdx.y, js = blockIdx.z; const int per = 2 * L / 32;
    float a = 0.f;
    for (int j = js * per; j < (js + 1) * per; ++j) a += fabsf(K2[((size_t)o * 2 * L + j) * 1024 + c]);
    np[(js * 2 + o) * 1024 + c] = a;
}
__global__ __launch_bounds__(256) void k_hy_sconv(const bf16_t* __restrict__ Z, const float* __restrict__ cw, const float* __restrict__ cb, float* __restrict__ U3) {
    const int r = blockIdx.x, tid = threadIdx.x;
    int l, L; if (r < MLAT) { l = r % SEQ; L = SEQ; } else { l = (r - MLAT) % CTXL; L = CTXL; }
    for (int ch = tid; ch < 3072; ch += 256) {
        const float xm = l > 0 ? bf2f(Z[(size_t)(r - 1) * NP + ZC_BU + ch]) : 0.f, x0 = bf2f(Z[(size_t)r * NP + ZC_BU + ch]), xp = l < L - 1 ? bf2f(Z[(size_t)(r + 1) * NP + ZC_BU + ch]) : 0.f;
        U3[(size_t)r * 3072 + ch] = xm * cw[ch] + x0 * cw[3072 + ch] + xp * cw[2 * 3072 + ch] + cb[ch];
    }
}
template <bool FINAL>
__global__ __launch_bounds__(256) void k_longconv(const float* __restrict__ vin, int vstride, const float* __restrict__ xmul, int xstride, const float* __restrict__ K2o, const float* __restrict__ np, int o,
                           const float* __restrict__ bias, const bf16_t* __restrict__ Z, float* __restrict__ z1out, bf16_t* __restrict__ ycat, int rowbase, int L) {
    const int tid = threadIdx.x, tc = tid & 15, tt = tid >> 4;
    const int c = blockIdx.x * 64 + tc * 4, t0 = blockIdx.y * 128 + tt * 8, b = blockIdx.z;
    const size_t rb = (size_t)rowbase + (size_t)b * L;
    const int mask = 2 * L - 1;
    f32x4 acc[8], kw[8];
#pragma unroll
    for (int i = 0; i < 8; ++i) { acc[i] = (f32x4){0, 0, 0, 0}; kw[i] = *(const f32x4*)(K2o + (size_t)((t0 + i) & mask) * 1024 + c); }
    for (int s = 0; s < L; ++s) {
        const f32x4 v = *(const f32x4*)(vin + (rb + s) * vstride + c);
#pragma unroll
        for (int i = 0; i < 8; ++i) acc[i] += v * kw[i];
#pragma unroll
        for (int i = 7; i > 0; --i) kw[i] = kw[i - 1];
        kw[0] = *(const f32x4*)(K2o + (size_t)((t0 - s - 1) & mask) * 1024 + c);
    }
    f32x4 nrm = {EPS, EPS, EPS, EPS};
    for (int js = 0; js < 32; ++js) nrm += *(const f32x4*)(np + (js * 2 + o) * 1024 + c);
    const f32x4 bi = *(const f32x4*)(bias + c);
#pragma unroll
    for (int i = 0; i < 8; ++i) {
        const size_t r = rb + t0 + i;
        const f32x4 vt = *(const f32x4*)(vin + r * vstride + c), xm = *(const f32x4*)(xmul + r * xstride + c);
        f32x4 res = xm * (acc[i] / nrm + bi * vt);
        if (FINAL) {
            float o4[4];
#pragma unroll
            for (int j = 0; j < 4; ++j) o4[j] = res[j] * silu_f(bf2f(Z[r * NP + ZC_BG + c + j]));
            u32x2 w; w.x = f2bf(o4[0]) | ((unsigned)f2bf(o4[1]) << 16); w.y = f2bf(o4[2]) | ((unsigned)f2bf(o4[3]) << 16);
            *(u32x2*)(ycat + r * D + 1024 + c) = w;
        } else *(f32x4*)(z1out + r * 1024 + c) = res;
    }
}

__device__ __forceinline__ int ml_row(int b, int dir, int p) {
    if (p < CTXL) { const int j = dir ? CTXL - 1 - p : p; return MLAT + b * CTXL + j; }
    int pp = p - CTXL; if (dir) pp = SEQ - 1 - pp; const int col = pp >> 6, row = pp & 63; return b * SEQ + row * 64 + col;
}
__device__ __forceinline__ int gla_row(int b, int dir, int p) {
    if (p < CTXL) { const int j = dir ? CTXL - 1 - p : p; return MLAT + b * CTXL + j; }
    int t = p - CTXL; if (dir) t = SEQ - 1 - t; return b * SEQ + t;
}
__global__ __launch_bounds__(256) void k_ml_prep(const bf16_t* __restrict__ Z, const float* __restrict__ cw  , const float* __restrict__ cb  , float* __restrict__ QC, float* __restrict__ KC) {
    const int r = blockIdx.x, tid = threadIdx.x;
    int rp = -1, rn = -1;
    if (r < MLAT) { const int b = r / SEQ, t = r % SEQ, row = t >> 6, col = t & 63, pp = col * 64 + row;
        if (pp > 0) { const int q = pp - 1; rp = b * SEQ + (q & 63) * 64 + (q >> 6); }
        if (pp < SEQ - 1) { const int q = pp + 1; rn = b * SEQ + (q & 63) * 64 + (q >> 6); }
    } else { const int j = (r - MLAT) % CTXL; if (j > 0) rp = r - 1; if (j < CTXL - 1) rn = r + 1; }
    for (int c = tid; c < 1024; c += 256) {
#pragma unroll
        for (int which = 0; which < 2; ++which) {
            const int zc = which ? ZC_CK : ZC_CQ;
            const float xm = rp >= 0 ? bf2f(Z[(size_t)rp * NP + zc + c]) : 0.f, x0 = bf2f(Z[(size_t)r * NP + zc + c]), xp = rn >= 0 ? bf2f(Z[(size_t)rn * NP + zc + c]) : 0.f;
            const float y = xm * cw[(which * 3 + 0) * 1024 + c] + x0 * cw[(which * 3 + 1) * 1024 + c] + xp * cw[(which * 3 + 2) * 1024 + c] + cb[which * 1024 + c];
            const float s = silu_f(y);
            if (which) KC[(size_t)r * 1024 + c] = s * 0.0625f; else QC[(size_t)r * 1024 + c] = s;
        }
    }
}
__global__ __launch_bounds__(256) void k_mlstm_naive(const float* __restrict__ QC, const float* __restrict__ KC, const bf16_t* __restrict__ Z, const float* __restrict__ ZG, const float* __restrict__ gate_b  , float* __restrict__ OM) {
    __shared__ float sq[16][256], sk[16][256], sv[16][16], sf[16], si[16], pnum[16][4][16], pden[16][4][16];
    __shared__ int srow[16];
    const int tid = threadIdx.x, kg = tid >> 4, j = tid & 15, wave = tid >> 6;
    const int seq = blockIdx.x >> 4, dvs = blockIdx.x & 15, b = seq >> 3, h = (seq >> 1) & 3, dir = seq & 1;
    float C[16], n[16];
#pragma unroll
    for (int i = 0; i < 16; ++i) { C[i] = 0.f; n[i] = 0.f; }
    for (int p0 = 0; p0 < SEQP; p0 += 16) {
        __syncthreads();
        if (tid < 16) { const int r = ml_row(b, dir, p0 + tid); srow[tid] = r;
            const float gi = ZG[(size_t)r * 256 + dir * 8 + h] + gate_b[dir * 8 + h], gf = ZG[(size_t)r * 256 + dir * 8 + 4 + h] + gate_b[dir * 8 + 4 + h];
            si[tid] = expf(gi); sf[tid] = sigmoid_f(gf); }
        __syncthreads();
        for (int idx = tid; idx < 16 * 256; idx += 256) { const int tt = idx >> 8, kk = idx & 255; const size_t r = srow[tt]; sq[tt][kk] = QC[r * 1024 + h * 256 + kk]; sk[tt][kk] = KC[r * 1024 + h * 256 + kk]; }
        { const int tt = tid >> 4, jj = tid & 15; sv[tt][jj] = bf2f(Z[(size_t)srow[tt] * NP + ZC_CV + h * 256 + dvs * 16 + jj]); }
        __syncthreads();
        for (int tt = 0; tt < 16; ++tt) {
            const float f = sf[tt], ig = si[tt], v = sv[tt][j];
            float num = 0.f, den = 0.f;
#pragma unroll
            for (int kk = 0; kk < 16; ++kk) { const float kx = sk[tt][kg * 16 + kk], qx = sq[tt][kg * 16 + kk];
                C[kk] = f * C[kk] + ig * kx * v; n[kk] = f * n[kk] + ig * kx; num += qx * C[kk]; den += qx * n[kk]; }
            num += __shfl_xor(num, 16); num += __shfl_xor(num, 32); den += __shfl_xor(den, 16); den += __shfl_xor(den, 32);
            if ((tid & 48) == 0) { pnum[tt][wave][j] = num; pden[tt][wave][j] = den; }
        }
        __syncthreads();
        { const int tt = tid >> 4; const float num = pnum[tt][0][j] + pnum[tt][1][j] + pnum[tt][2][j] + pnum[tt][3][j], den = pden[tt][0][j] + pden[tt][1][j] + pden[tt][2][j] + pden[tt][3][j];
            OM[((size_t)dir * MROWS + srow[tt]) * 1024 + h * 256 + dvs * 16 + j] = num / fmaxf(fabsf(den), 1.f); }
    }
}

__global__ __launch_bounds__(256) void k_gla_prep(const float* __restrict__ ZG, const float* __restrict__ w2  , const float* __restrict__ b2  , float* __restrict__ AL) {
    __shared__ float a[32];
    const int r = blockIdx.x, tid = threadIdx.x;
    if (tid < 32) a[tid] = ZG[(size_t)r * 256 + 16 + tid];
    __syncthreads();
    for (int i = tid; i < 1024; i += 256) { const int dir = i >> 9, nn = i & 511;
        float x = b2[dir * 512 + nn];
        for (int k = 0; k < 16; ++k) x += a[dir * 16 + k] * w2[(dir * 16 + k) * 512 + nn];
        AL[((size_t)dir * MROWS + r) * 512 + nn] = expf(logsigmoid_f(x) * (1.f / 16.f)); }
}
__global__ __launch_bounds__(256) void k_gla_naive(const bf16_t* __restrict__ Z, const float* __restrict__ AL, float* __restrict__ OG) {
    __shared__ float sq[16][128], sk[16][128], sa[16][128], sv[16][16], pnum[16][4][16];
    __shared__ int srow[16];
    const int tid = threadIdx.x, kg = tid >> 4, j = tid & 15, wave = tid >> 6;
    const int seq = blockIdx.x >> 4, dvs = blockIdx.x & 15, b = seq >> 3, h = (seq >> 1) & 3, dir = seq & 1;
    float S[8];
#pragma unroll
    for (int i = 0; i < 8; ++i) S[i] = 0.f;
    const float qs = 0.08838834764831845f;
    for (int p0 = 0; p0 < SEQP; p0 += 16) {
        __syncthreads();
        if (tid < 16) srow[tid] = gla_row(b, dir, p0 + tid);
        __syncthreads();
        for (int idx = tid; idx < 16 * 128; idx += 256) { const int tt = idx >> 7, kk = idx & 127; const size_t r = srow[tt];
            sq[tt][kk] = bf2f(Z[r * NP + ZC_DQ + h * 128 + kk]) * qs; sk[tt][kk] = bf2f(Z[r * NP + ZC_DK + h * 128 + kk]); sa[tt][kk] = AL[((size_t)dir * MROWS + r) * 512 + h * 128 + kk]; }
        { const int tt = tid >> 4, jj = tid & 15; sv[tt][jj] = bf2f(Z[(size_t)srow[tt] * NP + ZC_DV + h * 256 + dvs * 16 + jj]); }
        __syncthreads();
        for (int tt = 0; tt < 16; ++tt) {
            const float v = sv[tt][j]; float num = 0.f;
#pragma unroll
            for (int kk = 0; kk < 8; ++kk) { const float kx = sk[tt][kg * 8 + kk], qx = sq[tt][kg * 8 + kk], al = sa[tt][kg * 8 + kk];
                S[kk] = al * S[kk] + kx * v; num += qx * S[kk]; }
            num += __shfl_xor(num, 16); num += __shfl_xor(num, 32);
            if ((tid & 48) == 0) pnum[tt][wave][j] = num;
        }
        __syncthreads();
        { const int tt = tid >> 4; OG[((size_t)dir * MROWS + srow[tt]) * 1024 + h * 256 + dvs * 16 + j] = pnum[tt][0][j] + pnum[tt][1][j] + pnum[tt][2][j] + pnum[tt][3][j]; }
    }
}

__global__ __launch_bounds__(256) void k_combine(const bf16_t* __restrict__ Z, const float* __restrict__ OM, const float* __restrict__ OG, const float* __restrict__ gng, bf16_t* __restrict__ ycat) {
    const int r = blockIdx.x, tid = threadIdx.x, c = tid * 4;
    const f32x4 om = *(const f32x4*)(OM + (size_t)r * 1024 + c) + *(const f32x4*)(OM + ((size_t)MROWS + r) * 1024 + c);
    const f32x4 og = *(const f32x4*)(OG + (size_t)r * 1024 + c) + *(const f32x4*)(OG + ((size_t)MROWS + r) * 1024 + c);
    float ss = og[0] * og[0] + og[1] * og[1] + og[2] * og[2] + og[3] * og[3];
    for (int o = 32; o > 0; o >>= 1) ss += __shfl_xor(ss, o);
    const float rs = rsqrtf(ss * (1.f / 256.f) + EPS);
    float yc[4], yd[4];
#pragma unroll
    for (int j = 0; j < 4; ++j) {
        const float co = bf2f(Z[(size_t)r * NP + ZC_CO + c + j]), cg = bf2f(Z[(size_t)r * NP + ZC_CG + c + j]), dg = bf2f(Z[(size_t)r * NP + ZC_DG + c + j]);
        yc[j] = om[j] * sigmoid_f(co) * silu_f(cg);
        yd[j] = og[j] * rs * gng[c + j] * silu_f(dg);
    }
    u32x2 w; w.x = f2bf(yc[0]) | ((unsigned)f2bf(yc[1]) << 16); w.y = f2bf(yc[2]) | ((unsigned)f2bf(yc[3]) << 16);
    *(u32x2*)(ycat + (size_t)r * D + 2048 + c) = w;
    w.x = f2bf(yd[0]) | ((unsigned)f2bf(yd[1]) << 16); w.y = f2bf(yd[2]) | ((unsigned)f2bf(yd[3]) << 16);
    *(u32x2*)(ycat + (size_t)r * D + 3072 + c) = w;
}

struct WsMap {
    size_t wint[2], woutt[2], fnett[2], adapart, mod, h, z, zg, x1, ycat, uc, us, ya, u3, z1, k2lat, k2ctx, hid2, knp_lat, knp_ctx, qc, kc, om, og, al, end;
};
static WsMap make_map() {
    WsMap m; size_t o = 1u << 20;
    auto take = [&](size_t bytes) { size_t r = o; o += (bytes + 255) & ~(size_t)255; return r; };
    for (int l = 0; l < 2; ++l) m.wint[l] = take((size_t)NP * D * 2);
    for (int l = 0; l < 2; ++l) m.woutt[l] = take((size_t)D * D * 2);
    for (int l = 0; l < 2; ++l) m.fnett[l] = take((size_t)GW * GW * 2);
    m.adapart = take((size_t)2 * ADA_KS * 3 * 3 * D * 4); m.mod = take((size_t)2 * 3 * 3 * D * 4);
    m.h = take((size_t)MROWS * D * 2); m.z = take((size_t)MROWS * NP * 2); m.zg = take((size_t)MROWS * 256 * 4);
    m.x1 = take((size_t)MROWS * D * 4); m.ycat = take((size_t)MROWS * D * 2);
    m.uc = take((size_t)MROWS * 1024 * 4); m.us = take((size_t)MROWS * 1024 * 4); m.ya = take((size_t)MROWS * 1024 * 2);
    m.u3 = take((size_t)MROWS * 3072 * 4); m.z1 = take((size_t)MROWS * 1024 * 4);
    m.k2lat = take((size_t)2 * 2 * SEQ * 1024 * 4); m.k2ctx = take((size_t)2 * 2 * CTXL * 1024 * 4); m.hid2 = take((size_t)SEQ * 64 * 4);
    m.knp_lat = take((size_t)32 * 2 * 1024 * 4); m.knp_ctx = take((size_t)32 * 2 * 1024 * 4);
    m.qc = take((size_t)MROWS * 1024 * 4); m.kc = take((size_t)MROWS * 1024 * 4);
    m.om = take((size_t)2 * MROWS * 1024 * 4); m.og = take((size_t)2 * MROWS * 1024 * 4); m.al = take((size_t)2 * MROWS * 512 * 4);
    m.end = o; return m;
}
template <class Epi> static void launch_gemm(const pg8::Gemm& g, const Epi& E, int grid, hipStream_t st) {
    static bool attr = false;
    if (!attr) { if (hipFuncSetAttribute((const void*)k_gemm<Epi>, hipFuncAttributeMaxDynamicSharedMemorySize, pg8::STAGE_BYTES) != hipSuccess) fprintf(stderr, "hipFuncSetAttribute failed\n"); attr = true; }
    hipLaunchKernelGGL((k_gemm<Epi>), dim3(grid), dim3(512), pg8::STAGE_BYTES, st, g, E);
}

extern "C" void kernel_launch(void* const* d_in, const int* in_sizes, int n_in, void* d_out, int out_size, void* d_ws, size_t ws_size, hipStream_t stream) {
    static WsMap m = make_map();
    static int ncu = 0;
    if (!ncu) { int dev = 0; hipGetDevice(&dev); hipDeviceGetAttribute(&ncu, hipDeviceAttributeMultiprocessorCount, dev); if (ncu <= 0) ncu = 256; }
    if (ws_size < m.end || n_in != 26) { fprintf(stderr, "kernel_launch: need %zu bytes of workspace (have %zu), 26 inputs (have %d)\n", m.end, ws_size, n_in); return; }
    char* ws = (char*)d_ws;
    const float* x = (const float*)d_in[0]; const float* c = (const float*)d_in[1]; const float* ctx = (const float*)d_in[2]; const float* c_ctx = (const float*)d_in[3];
    const float* ada_w = (const float*)d_in[4]; const float* ada_b = (const float*)d_in[5]; const float* norm_g = (const float*)d_in[6]; const float* w_in = (const float*)d_in[7];
    const float* fnet_w = (const float*)d_in[8]; const float* hy_conv_w = (const float*)d_in[9]; const float* hy_conv_b = (const float*)d_in[10];
    const float* hy_f_w1 = (const float*)d_in[11]; const float* hy_f_b1 = (const float*)d_in[12]; const float* hy_f_w2 = (const float*)d_in[13]; const float* hy_f_b2 = (const float*)d_in[14];
    const float* hy_f_w3 = (const float*)d_in[15]; const float* hy_f_freq = (const float*)d_in[16]; const float* hy_bias = (const float*)d_in[17];
    const float* ml_conv_w = (const float*)d_in[18]; const float* ml_conv_b = (const float*)d_in[19]; const float* ml_gate_b = (const float*)d_in[20];
    const float* gla_w2 = (const float*)d_in[21]; const float* gla_b2 = (const float*)d_in[22]; const float* gla_norm_g = (const float*)d_in[23];
    const float* w_out = (const float*)d_in[24]; const float* final_g = (const float*)d_in[25];
    bf16_t* H = (bf16_t*)(ws + m.h); bf16_t* Z = (bf16_t*)(ws + m.z); float* ZG = (float*)(ws + m.zg); float* X1 = (float*)(ws + m.x1); bf16_t* YCAT = (bf16_t*)(ws + m.ycat);
    float* UC = (float*)(ws + m.uc); float* US = (float*)(ws + m.us); bf16_t* YA = (bf16_t*)(ws + m.ya); float* U3 = (float*)(ws + m.u3); float* Z1 = (float*)(ws + m.z1);
    float* K2L = (float*)(ws + m.k2lat); float* K2C = (float*)(ws + m.k2ctx); float* HID2 = (float*)(ws + m.hid2); float* KNL = (float*)(ws + m.knp_lat); float* KNC = (float*)(ws + m.knp_ctx);
    float* QC = (float*)(ws + m.qc); float* KC = (float*)(ws + m.kc); float* OM = (float*)(ws + m.om); float* OG = (float*)(ws + m.og); float* AL = (float*)(ws + m.al);
    float* ADAP = (float*)(ws + m.adapart); float* MOD = (float*)(ws + m.mod);

    for (int l = 0; l < 2; ++l) {
        hipLaunchKernelGGL(k_transpose, dim3(NP / 64, D / 64), dim3(256), 0, stream, w_in + (size_t)l * D * PROJ_W, (bf16_t*)(ws + m.wint[l]), D, PROJ_W, 1);
        hipLaunchKernelGGL(k_transpose, dim3(D / 64, D / 64), dim3(256), 0, stream, w_out + (size_t)l * D * D, (bf16_t*)(ws + m.woutt[l]), D, D, 0);
        hipLaunchKernelGGL(k_transpose, dim3(GW / 64, GW / 64), dim3(256), 0, stream, fnet_w + (size_t)l * GW * GW, (bf16_t*)(ws + m.fnett[l]), GW, GW, 0);
    }
    hipLaunchKernelGGL(k_ada_partial, dim3(12, ADA_KS, 2), dim3(256), 0, stream, c, c_ctx, ada_w, ADAP);
    hipLaunchKernelGGL(k_mod_final, dim3(2 * 3 * 3 * D / 256), dim3(256), 0, stream, ADAP, ada_b, MOD);

    for (int l = 0; l < 2; ++l) {
        const float* modl = MOD + (size_t)l * 9 * D;
        const float* xlat = l == 0 ? x : X1; const float* xctx = l == 0 ? ctx : X1 + (size_t)MLAT * D;
        hipLaunchKernelGGL(k_norm_mod, dim3(MROWS), dim3(256), 0, stream, xlat, xctx, norm_g + l * D, modl, H);
        { pg8::Gemm g{H, (const bf16_t*)(ws + m.wint[l]), MROWS, NP, D}; EpiInProj E{Z, ZG}; launch_gemm(g, E, ncu, stream); }
        hipLaunchKernelGGL(k_chdft, dim3(MROWS), dim3(256), 0, stream, Z, UC, US);
        hipLaunchKernelGGL(k_seqdft, dim3(16, SEQ / 64, NB), dim3(256), 0, stream, UC, US, YA, 0, SEQ, 1.0f / sqrtf((float)SEQ * 256.f));
        hipLaunchKernelGGL(k_seqdft, dim3(16, CTXL / 64, NB), dim3(256), 0, stream, UC, US, YA, MLAT, CTXL, 1.0f / sqrtf((float)CTXL * 256.f));
        { pg8::Gemm g{YA, (const bf16_t*)(ws + m.fnett[l]), MROWS, GW, GW}; EpiFnet E{Z, YCAT}; launch_gemm(g, E, ncu, stream); }
        for (int seg = 0; seg < 2; ++seg) {
            const int L = seg ? CTXL : SEQ; float* K2 = seg ? K2C : K2L; float* KN = seg ? KNC : KNL;
            hipLaunchKernelGGL(k_hy_hid, dim3(L), dim3(64), 0, stream, hy_f_w1 + l * 33 * 64, hy_f_b1 + l * 64, hy_f_w2 + l * 64 * 64, hy_f_b2 + l * 64, hy_f_freq + l * 128, HID2, L);
            hipLaunchKernelGGL(k_hy_filt, dim3(L, 4), dim3(256), 0, stream, HID2, hy_f_w3 + (size_t)l * 64 * 4096, K2, L);
            hipLaunchKernelGGL(k_hy_norm, dim3(4, 2, 32), dim3(256), 0, stream, K2, KN, L);
        }
        hipLaunchKernelGGL(k_hy_sconv, dim3(MROWS), dim3(256), 0, stream, Z, hy_conv_w + (size_t)l * 3 * 3072, hy_conv_b + l * 3072, U3);
        for (int seg = 0; seg < 2; ++seg) {
            const int L = seg ? CTXL : SEQ; const int rb = seg ? MLAT : 0; float* K2 = seg ? K2C : K2L; float* KN = seg ? KNC : KNL;
            hipLaunchKernelGGL((k_longconv<false>), dim3(16, L / 128, NB), dim3(256), 0, stream, U3, 3072, U3 + 1024, 3072, K2, KN, 0, hy_bias + l * 2048, Z, Z1, YCAT, rb, L);
            hipLaunchKernelGGL((k_longconv<true>), dim3(16, L / 128, NB), dim3(256), 0, stream, Z1, 1024, U3 + 2048, 3072, K2 + (size_t)2 * L * 1024, KN, 1, hy_bias + l * 2048 + 1024, Z, Z1, YCAT, rb, L);
        }
        hipLaunchKernelGGL(k_ml_prep, dim3(MROWS), dim3(256), 0, stream, Z, ml_conv_w + (size_t)l * 6 * 1024, ml_conv_b + l * 2048, QC, KC);
        hipLaunchKernelGGL(k_mlstm_naive, dim3(256), dim3(256), 0, stream, QC, KC, Z, ZG, ml_gate_b + l * 16, OM);
        hipLaunchKernelGGL(k_gla_prep, dim3(MROWS), dim3(256), 0, stream, ZG, gla_w2 + (size_t)l * 2 * 16 * 512, gla_b2 + l * 1024, AL);
        hipLaunchKernelGGL(k_gla_naive, dim3(256), dim3(256), 0, stream, Z, AL, OG);
        hipLaunchKernelGGL(k_combine, dim3(MROWS), dim3(256), 0, stream, Z, OM, OG, gla_norm_g + l * 1024, YCAT);
        { pg8::Gemm g{YCAT, (const bf16_t*)(ws + m.woutt[l]), l == 0 ? MROWS : MLAT, D, D}; EpiOut E{xlat, xctx, modl, X1}; launch_gemm(g, E, ncu, stream); }
    }
    hipLaunchKernelGGL(k_final_norm, dim3(MLAT), dim3(256), 0, stream, X1, final_g, (float*)d_out);
}
```

```cpp
#include <hip/hip_runtime.h>
#include <stdio.h>
#include <stdint.h>
#include <math.h>

#include <string.h>
namespace pg8 {
#define PG8_LAS __attribute__((address_space(3)))
typedef unsigned short bf16_t;
typedef short bf16x8 __attribute__((ext_vector_type(8)));
typedef float f32x4 __attribute__((ext_vector_type(4)));
typedef unsigned u32x4 __attribute__((ext_vector_type(4)));
constexpr int BM = 256, BK = 64, HALF = 128, HTB = HALF * BK * 2  , STAGE_BYTES = 8 * HTB, NXCD = 8, WGM = 8;

__host__ __device__ __forceinline__ int lds_byte(int r, int c) { const int st = (r >> 4) * 2 + (c >> 5), rr = r & 15, cc = c & 31, ob = rr * 64 + cc * 2; return st * 1024 + (ob ^ (((ob >> 9) & 1) << 5)); }
__host__ __device__ __forceinline__ void stage_rc(int b, int& R, int& C) { const int st = b / 1024, sb = b % 1024, swz = sb ^ (((sb >> 9) & 1) << 5); R = (st >> 1) * 16 + swz / 64; C = (st & 1) * 32 + (swz % 64) / 2; }
__host__ __device__ __forceinline__ int perm32(int rho) { const int n = rho >> 4, i = rho & 15; return 8 * (i >> 2) + 4 * n + (i & 3); }

struct Unit { const char* a; const char* b; int pm, pn, aux; };
struct Gemm { const bf16_t* A; const bf16_t* Bt; int M, N, K, lda, ldb, pad; };

struct StaticOrder {
    int nM, nN, nwg, G, c; const char* A; const char* B; size_t tsA, tsB;
    __host__ __device__ void init(const Gemm& g, int G_, int c_) { nM = g.M / BM; nN = g.N / BM; nwg = nM * nN; G = G_; c = c_; A = (const char*)g.A; B = (const char*)g.Bt; tsA = (size_t)BM * g.lda * 2; tsB = (size_t)BM * g.ldb * 2; }
    __host__ __device__ bool next(int i, Unit& u) const {
        const long L = (long)i * G + c; if (L >= nwg) return false;
        int wgid = (int)L; { const int q = nwg / NXCD, r = nwg % NXCD, xcd = wgid % NXCD, off = wgid / NXCD; wgid = (xcd < r ? xcd * (q + 1) : r * (q + 1) + (xcd - r) * q) + off; }
        const int nig = WGM * nN, gid = wgid / nig, fm = gid * WGM, gsz = (nM - fm) < WGM ? (nM - fm) : WGM;
        u.pm = fm + ((wgid % nig) % gsz); u.pn = (wgid % nig) / gsz; u.aux = 0; u.a = A + (size_t)u.pm * tsA; u.b = B + (size_t)u.pn * tsB; return true;
    }
    __device__ __forceinline__ void a_ready(const Unit&) const {}
    __device__ __forceinline__ void done(const Unit&) const {}
};

__device__ __forceinline__ unsigned cvt_pk_bf16(float lo, float hi) { unsigned r; asm volatile("v_cvt_pk_bf16_f32 %0, %1, %2" : "=v"(r) : "v"(lo), "v"(hi)); return r; }

template <class Epi, class Sched, bool STAMP = false>
__device__ __forceinline__ void gemm_phase(PG8_LAS unsigned char* lds, const Gemm g, const Sched& S, const Epi& E, unsigned long long* stamps) {
    int tid_l = threadIdx.x; asm volatile("" : "+v"(tid_l));
    const int tid = tid_l, wid = __builtin_amdgcn_readfirstlane(tid >> 6), lane = tid & 63, wr = wid >> 2, wc = wid & 3, fr = lane & 15, fq = lane >> 4;
    const int K = g.K, nt = K / BK;
    int ts_lo = 0, ts_hi = 0, nts = 0; const unsigned long long rt_entry = STAMP ? (unsigned long long)wall_clock64() : 0ull;
#define PG8_STAMP() do { if (STAMP && wid == 0 && nts < 64) { const unsigned long long _c = (unsigned long long)clock64(); \
        ts_lo = (lane == nts) ? (int)(unsigned)_c : ts_lo; ts_hi = (lane == nts) ? (int)(unsigned)(_c >> 32) : ts_hi; ++nts; } } while (0)
    PG8_STAMP();
    unsigned voffA[2], voffB[2];
#pragma unroll
    for (int i = 0; i < 2; ++i) { int R, C; stage_rc(tid * 16 + i * 8192, R, C); const int Rb = Epi::PERM ? ((R & ~31) + perm32(R & 31)) : R;
        voffA[i] = (unsigned)(R * g.lda + C) * 2u; voffB[i] = (unsigned)(Rb * g.ldb + C) * 2u; }
    const size_t kstep = (size_t)(BK * 2);
    const size_t hstepA = (size_t)HALF * g.lda * 2, hstepB = (size_t)HALF * g.ldb * 2;
    const unsigned ldsw = (unsigned)wid * 1024u;
    const int aoff = lds_byte(wr * 64 + fr, fq * 8), boff = lds_byte(wc * 32 + fr, fq * 8);
#define PG8_SA(b, h) (((b) * 2 + (h)) * HTB)
#define PG8_SB(b, h) ((4 + (b) * 2 + (h)) * HTB)
#define PG8_STAGE(bufoff, gbase, voff) do { _Pragma("unroll") for (int _i = 0; _i < 2; ++_i) \
        __builtin_amdgcn_global_load_lds((const unsigned*)((const char*)(gbase) + (voff)[_i]), (PG8_LAS unsigned*)(lds + (bufoff) + ldsw + _i * 8192), 16, 0, 0); } while (0)
#define PG8_LDA(dst, b, h) do { _Pragma("unroll") for (int m = 0; m < 4; ++m) _Pragma("unroll") for (int k = 0; k < 2; ++k) dst[m][k] = *(const PG8_LAS bf16x8*)(lds + PG8_SA(b, h) + aoff + m * 2048 + k * 1024); } while (0)
#define PG8_LDB(dst, b, h) do { _Pragma("unroll") for (int n = 0; n < 2; ++n) _Pragma("unroll") for (int k = 0; k < 2; ++k) dst[n][k] = *(const PG8_LAS bf16x8*)(lds + PG8_SB(b, h) + boff + n * 2048 + k * 1024); } while (0)
#define PG8_MMA(ai, bj, At, Bt) do { __builtin_amdgcn_s_setprio(1); _Pragma("unroll") for (int m = 0; m < 4; ++m) _Pragma("unroll") for (int n = 0; n < 2; ++n) _Pragma("unroll") for (int k = 0; k < 2; ++k) \
        acc[ai][bj][m][n] = __builtin_amdgcn_mfma_f32_16x16x32_bf16(Bt[n][k], At[m][k], acc[ai][bj][m][n], 0, 0, 0); __builtin_amdgcn_s_setprio(0); } while (0)
#define PG8_WAIT_V(n) asm volatile("s_waitcnt vmcnt(" #n ")" ::: "memory")
#define PG8_WAIT_L(n) asm volatile("s_waitcnt lgkmcnt(" #n ")" ::: "memory")
#define PG8_BAR __builtin_amdgcn_s_barrier()
#define PG8_SCHED __builtin_amdgcn_sched_barrier(0)
    Unit cur, nxt; int ui = 0;
    if (!S.next(0, cur)) return;
    f32x4 acc[2][2][4][2];
#pragma unroll
    for (int a = 0; a < 2; ++a)
#pragma unroll
        for (int b = 0; b < 2; ++b)
#pragma unroll
            for (int m = 0; m < 4; ++m)
#pragma unroll
                for (int n = 0; n < 2; ++n) acc[a][b][m][n] = (f32x4){0.f, 0.f, 0.f, 0.f};
    bf16x8 At[4][2], B0[2][2], B1[2][2];
    const char* cA = cur.a; const char* cB = cur.b;
    S.a_ready(cur);
    PG8_STAGE(PG8_SB(0, 0), cB, voffB); PG8_STAGE(PG8_SA(0, 0), cA, voffA); PG8_STAGE(PG8_SB(0, 1), cB + hstepB, voffB); PG8_STAGE(PG8_SA(0, 1), cA + hstepA, voffA);
    if (wr == 1) PG8_BAR;
    PG8_WAIT_V(4); PG8_BAR;
    PG8_STAGE(PG8_SB(1, 0), cB + kstep, voffB); PG8_STAGE(PG8_SA(1, 0), cA + kstep, voffA); PG8_STAGE(PG8_SB(1, 1), cB + hstepB + kstep, voffB);
    PG8_WAIT_V(6); PG8_BAR;
    PG8_STAMP();
    for (;;) {
        const bool has_next = S.next(ui + 1, nxt);
        const char* nA = has_next ? nxt.a : cA; const char* nB = has_next ? nxt.b : cB;
        for (int t = 0; t < nt; t += 2) {
            const bool last = (t == nt - 2);
            const char* a1 = cA + (size_t)(t + 1) * kstep;
            const char* a2 = last ? nA : cA + (size_t)(t + 2) * kstep; const char* b2 = last ? nB : cB + (size_t)(t + 2) * kstep;
            const char* a3 = a2 + kstep; const char* b3 = b2 + kstep;
            if (last && has_next) S.a_ready(nxt);
            PG8_LDB(B0, 0, 0); PG8_SCHED; PG8_LDA(At, 0, 0); PG8_STAGE(PG8_SA(1, 1), a1 + hstepA, voffA);
            PG8_WAIT_L(8); PG8_BAR; PG8_WAIT_L(0); PG8_MMA(0, 0, At, B0); PG8_BAR; PG8_SCHED;
            PG8_LDB(B1, 0, 1); PG8_STAGE(PG8_SB(0, 0), b2, voffB);
            PG8_BAR; PG8_WAIT_L(0); PG8_MMA(0, 1, At, B1); PG8_BAR;
            PG8_LDA(At, 0, 1); PG8_STAGE(PG8_SA(0, 0), a2, voffA);
            PG8_BAR; PG8_WAIT_L(0); PG8_MMA(1, 0, At, B0); PG8_BAR; PG8_SCHED;
            PG8_STAGE(PG8_SB(0, 1), b2 + hstepB, voffB);
            PG8_WAIT_V(6); PG8_BAR; PG8_MMA(1, 1, At, B1); PG8_BAR;
            PG8_LDB(B0, 1, 0); PG8_SCHED; PG8_LDA(At, 1, 0); PG8_STAGE(PG8_SA(0, 1), a2 + hstepA, voffA);
            PG8_WAIT_L(8); PG8_BAR; PG8_WAIT_L(0); PG8_MMA(0, 0, At, B0); PG8_BAR; PG8_SCHED;
            PG8_LDB(B1, 1, 1); PG8_STAGE(PG8_SB(1, 0), b3, voffB);
            PG8_BAR; PG8_WAIT_L(0); PG8_MMA(0, 1, At, B1); PG8_BAR;
            PG8_LDA(At, 1, 1); PG8_STAGE(PG8_SA(1, 0), a3, voffA);
            PG8_BAR; PG8_WAIT_L(0); PG8_MMA(1, 0, At, B0); PG8_BAR; PG8_SCHED;
            PG8_STAGE(PG8_SB(1, 1), b3 + hstepB, voffB);
            PG8_WAIT_V(6); PG8_BAR; PG8_MMA(1, 1, At, B1); PG8_BAR;
        }
        PG8_STAMP();
        if constexpr (!Epi::AFTER_DRAIN) { E(acc, cur, wr, wc, fr, fq); S.done(cur); }
        PG8_STAMP();
        if (!has_next) break;
#pragma unroll
        for (int a = 0; a < 2; ++a)
#pragma unroll
            for (int b = 0; b < 2; ++b)
#pragma unroll
                for (int m = 0; m < 4; ++m)
#pragma unroll
                    for (int n = 0; n < 2; ++n) acc[a][b][m][n] = (f32x4){0.f, 0.f, 0.f, 0.f};
        cur = nxt; cA = nA; cB = nB; ++ui;
    }
    PG8_WAIT_V(0);
    if (wr == 0) PG8_BAR;
    PG8_BAR;
    if constexpr (Epi::AFTER_DRAIN) { E.fused(acc, cur, wr, wc, fr, fq, lds, wid, lane); S.done(cur); }
    PG8_STAMP();
    if (STAMP && wid == 0) { stamps[lane] = lane < nts ? (((unsigned long long)(unsigned)ts_hi << 32) | (unsigned)ts_lo) : 0ull;
        if (lane == 62) stamps[62] = rt_entry; if (lane == 63) stamps[63] = (unsigned long long)wall_clock64(); }
#undef PG8_STAMP
#undef PG8_SA
#undef PG8_SB
#undef PG8_STAGE
#undef PG8_LDA
#undef PG8_LDB
#undef PG8_MMA
#undef PG8_WAIT_V
#undef PG8_WAIT_L
#undef PG8_BAR
#undef PG8_SCHED
}
}

typedef unsigned short bf16_t;
typedef float f32x4 __attribute__((ext_vector_type(4)));
typedef unsigned u32x4 __attribute__((ext_vector_type(4)));
typedef unsigned u32x2 __attribute__((ext_vector_type(2)));
#define LAS __attribute__((address_space(3)))

constexpr int D = 4096, NB = 2, SEQ = 4096, CTXL = 256, GW = 1024;
constexpr int MLAT = NB * SEQ, MCTX = NB * CTXL, MROWS = MLAT + MCTX;
constexpr int PROJ_W = 14384, NP = 14592;
constexpr int ZC_AU = 0, ZC_AG = 1024, ZC_BU = 2048, ZC_BG = 5120, ZC_CQ = 6144, ZC_CK = 7168, ZC_CV = 8192, ZC_CO = 9216, ZC_CG = 10240,
              ZC_DQ = 11264, ZC_DK = 11776, ZC_DV = 12288, ZC_DG = 13312, ZC_GATE = 14336;
constexpr int NTN_IN = NP / 256;
constexpr float EPS = 1e-6f;
constexpr int ADA_KS = 32;
constexpr int SEQP = CTXL + SEQ;

__device__ __forceinline__ int lnd(int v) {
#ifndef EMU
    asm volatile("" : "+v"(v));
#endif
    return v;
}
__device__ __forceinline__ void blk_sync() {
    __syncthreads();
}
__device__ __forceinline__ void lds_sync() {
#ifndef EMU
    asm volatile("s_waitcnt lgkmcnt(0)\n\ts_barrier" ::: "memory");
#else
    __syncthreads();
#endif
}
__device__ __forceinline__ float bf2f(bf16_t b) { return __uint_as_float(((unsigned)b) << 16); }
__device__ __forceinline__ bf16_t f2bf(float f) { unsigned u = __float_as_uint(f); u += 0x7FFFu + ((u >> 16) & 1u); return (bf16_t)(u >> 16); }
__device__ __forceinline__ float fexp(float x) { return __expf(x); }
__device__ __forceinline__ float frcp(float x) { return __builtin_amdgcn_rcpf(x); }
__device__ __forceinline__ float silu_f(float x) { return x * frcp(1.f + fexp(-x)); }
__device__ __forceinline__ float sigmoid_f(float x) { return frcp(1.f + fexp(-x)); }
__device__ __forceinline__ float logsigmoid_f(float x) { return fminf(x, 0.f) - log1pf(expf(-fabsf(x))); }
__device__ __forceinline__ float logsigmoid_fast(float x) { return fminf(x, 0.f) - __logf(1.f + fexp(-fabsf(x))); }

__device__ __forceinline__ int win_colmap(int n) {
    if (n < 11264) return n;
    if (n < 14336) return n + 16;
    if (n < 14352) return n - 14336 + 11264;
    if (n < 14384) return n;
    return -1;
}
constexpr float HY_FAST = -15.350567286626973f, HY_SLOW = -3.0701134573253946f;
#define HD __host__ __device__ __forceinline__
typedef float cf __attribute__((ext_vector_type(2)));
#if defined(__HIP_DEVICE_COMPILE__) && !defined(EMU)
#define CF_ASM 1
#endif
HD inline cf cmul(cf a, cf b) {
#ifdef CF_ASM
    cf t, r;
    asm("v_pk_mul_f32 %0, %1, %2 op_sel:[0,0] op_sel_hi:[0,1]" : "=v"(t) : "v"(a), "v"(b));
    asm("v_pk_fma_f32 %0, %1, %2, %3 op_sel:[1,1,0] op_sel_hi:[1,0,1] neg_lo:[0,1,0]" : "=v"(r) : "v"(a), "v"(b), "v"(t));
    return r;
#else
    return cf{a.x * b.x - a.y * b.y, a.x * b.y + a.y * b.x};
#endif
}
HD inline cf cmulc(cf a, cf b) {
#ifdef CF_ASM
    cf t, r;
    asm("v_pk_mul_f32 %0, %1, %2 op_sel:[0,0] op_sel_hi:[0,1] neg_hi:[0,1]" : "=v"(t) : "v"(a), "v"(b));
    asm("v_pk_fma_f32 %0, %1, %2, %3 op_sel:[1,1,0] op_sel_hi:[1,0,1]" : "=v"(r) : "v"(a), "v"(b), "v"(t));
    return r;
#else
    return cf{a.x * b.x + a.y * b.y, a.y * b.x - a.x * b.y};
#endif
}
HD inline cf cadd_mi(cf a, cf b) {
#ifdef CF_ASM
    cf r; asm("v_pk_add_f32 %0, %1, %2 op_sel:[0,1] op_sel_hi:[1,0] neg_hi:[0,1]" : "=v"(r) : "v"(a), "v"(b)); return r;
#else
    return cf{a.x + b.y, a.y - b.x};
#endif
}
HD inline cf cadd_pi(cf a, cf b) {
#ifdef CF_ASM
    cf r; asm("v_pk_add_f32 %0, %1, %2 op_sel:[0,1] op_sel_hi:[1,0] neg_lo:[0,1]" : "=v"(r) : "v"(a), "v"(b)); return r;
#else
    return cf{a.x - b.y, a.y + b.x};
#endif
}
template <int SIGN> HD inline void dft4(cf& a, cf& b, cf& c, cf& d) {
    const cf s0 = a + c, d0 = a - c, s1 = b + d, d1 = b - d;
    a = s0 + s1; c = s0 - s1;
    if (SIGN < 0) { b = cadd_mi(d0, d1); d = cadd_pi(d0, d1); }
    else          { b = cadd_pi(d0, d1); d = cadd_mi(d0, d1); }
}
#define DFT16_T(k) ((((k) & 3) << 2) | ((k) >> 2))
template <int SIGN, bool TIN = false> HD inline void dft16(cf (&x)[16]) {
    const float C1 = 0.92387953251128674f, S1 = 0.38268343236508977f, R2 = 0.70710678118654752f;
    const float sg = SIGN < 0 ? -1.f : 1.f;
    const cf w1{C1, sg * S1}, w2{R2, sg * R2}, w3{S1, sg * C1}, w4{0.f, sg}, w6{-R2, sg * R2}, w9{-C1, -sg * S1};
    if (!TIN) {
#pragma unroll
        for (int n2 = 0; n2 < 4; ++n2) dft4<SIGN>(x[n2], x[4 + n2], x[8 + n2], x[12 + n2]);
        x[4 * 1 + 1] = cmul(x[4 * 1 + 1], w1); x[4 * 1 + 2] = cmul(x[4 * 1 + 2], w2); x[4 * 1 + 3] = cmul(x[4 * 1 + 3], w3);
        x[4 * 2 + 1] = cmul(x[4 * 2 + 1], w2); x[4 * 2 + 2] = cmul(x[4 * 2 + 2], w4); x[4 * 2 + 3] = cmul(x[4 * 2 + 3], w6);
        x[4 * 3 + 1] = cmul(x[4 * 3 + 1], w3); x[4 * 3 + 2] = cmul(x[4 * 3 + 2], w6); x[4 * 3 + 3] = cmul(x[4 * 3 + 3], w9);
#pragma unroll
        for (int k1 = 0; k1 < 4; ++k1) dft4<SIGN>(x[4 * k1], x[4 * k1 + 1], x[4 * k1 + 2], x[4 * k1 + 3]);
    } else {
#pragma unroll
        for (int n2 = 0; n2 < 4; ++n2) dft4<SIGN>(x[4 * n2], x[4 * n2 + 1], x[4 * n2 + 2], x[4 * n2 + 3]);
        x[4 * 1 + 1] = cmul(x[4 * 1 + 1], w1); x[4 * 2 + 1] = cmul(x[4 * 2 + 1], w2); x[4 * 3 + 1] = cmul(x[4 * 3 + 1], w3);
        x[4 * 1 + 2] = cmul(x[4 * 1 + 2], w2); x[4 * 2 + 2] = cmul(x[4 * 2 + 2], w4); x[4 * 3 + 2] = cmul(x[4 * 3 + 2], w6);
        x[4 * 1 + 3] = cmul(x[4 * 1 + 3], w3); x[4 * 2 + 3] = cmul(x[4 * 2 + 3], w6); x[4 * 3 + 3] = cmul(x[4 * 3 + 3], w9);
#pragma unroll
        for (int k1 = 0; k1 < 4; ++k1) dft4<SIGN>(x[k1], x[4 + k1], x[8 + k1], x[12 + k1]);
    }
}
constexpr int FFT_BUF_OFF = 0, FFT_BUF_BYTES = 34816, FFT_RED_OFF = FFT_BUF_OFF + 2 * FFT_BUF_BYTES, FFT_UROW_OFF = FFT_RED_OFF + 1024, FFT_Z1_OFF = FFT_UROW_OFF + 3 * 2 * SEQ * 2 + 64, FFT_LDS_BYTES = FFT_Z1_OFF + SEQ * 8;
struct FftTw { cf wa, wb, w8; };
#ifndef EMU
__device__ __forceinline__ float hw_sin_rev(float r) { return __builtin_amdgcn_sinf(r); }
__device__ __forceinline__ float hw_cos_rev(float r) { return __builtin_amdgcn_cosf(r); }
#else
inline float hw_sin_rev(float r) { return (float)sin(2.0 * M_PI * (double)r); }
inline float hw_cos_rev(float r) { return (float)cos(2.0 * M_PI * (double)r); }
#endif
#ifndef EMU
#define FFT_SCHED_FENCE(q) do { if (((q) & 3) == 3) __builtin_amdgcn_sched_barrier(0); } while (0)
#else
#define FFT_SCHED_FENCE(q) do { } while (0)
#endif
__device__ __forceinline__ int fft_launder(int v) {
#ifndef EMU
    asm volatile("" : "+v"(v));
#endif
    return v;
}
__device__ __forceinline__ cf fft_opaque(cf v) {
#ifndef EMU
    float a = v.x, b = v.y; asm volatile("" : "+v"(a), "+v"(b)); return cf{a, b};
#else
    return v;
#endif
}
__device__ __forceinline__ FftTw fft_make_tw(int t) {
    FftTw w;
    const float ra = (float)t * (1.0f / 4096.0f), rb = (float)(t & 15) * (1.0f / 256.0f), r8 = (float)t * (1.0f / 8192.0f);
    w.wa = cf{hw_cos_rev(ra), -hw_sin_rev(ra)}; w.wb = cf{hw_cos_rev(rb), -hw_sin_rev(rb)}; w.w8 = cf{hw_cos_rev(r8), -hw_sin_rev(r8)};
    return w;
}
__device__ __forceinline__ void fft4096_fwd(cf (&x)[16], int t, LAS cf* buf, const FftTw& w) {
    const int s1 = t + (t >> 4), s2 = 272 * (t >> 4) + (t & 15), s3 = 17 * t;
    dft16<-1>(x);
    { const cf w1 = fft_opaque(w.wa); cf wp = w1; buf[s1] = x[0];
#pragma unroll
      for (int p = 1; p < 16; ++p) { buf[s1 + 272 * p] = cmul(x[DFT16_T(p)], wp); wp = cmul(wp, w1); } }
    blk_sync();
#pragma unroll
    for (int q = 0; q < 16; ++q) x[q] = buf[s2 + 17 * q];
    dft16<-1>(x);
    { const cf w1 = fft_opaque(w.wb); cf wp = w1; buf[s2] = x[0];
#pragma unroll
      for (int p = 1; p < 16; ++p) { buf[s2 + 17 * p] = cmul(x[DFT16_T(p)], wp); wp = cmul(wp, w1); } }
    blk_sync();
#pragma unroll
    for (int q = 0; q < 16; ++q) x[q] = buf[s3 + q];
    dft16<-1>(x);
}
__device__ __forceinline__ void fft4096_inv(cf (&x)[16], int t, LAS cf* buf, const FftTw& w) {
    const int s1 = t + (t >> 4), s2 = 272 * (t >> 4) + (t & 15), s3 = 17 * t;
    dft16<1, true>(x);
#pragma unroll
    for (int q = 0; q < 16; ++q) buf[s3 + q] = x[q];
    blk_sync();
    { const cf w1 = fft_opaque(w.wb); cf wp = w1; x[0] = buf[s2];
#pragma unroll
      for (int p = 1; p < 16; ++p) { x[p] = cmulc(buf[s2 + 17 * p], wp); wp = cmul(wp, w1); } }
    dft16<1>(x);
#pragma unroll
    for (int q = 0; q < 16; ++q) buf[s2 + 17 * q] = x[DFT16_T(q)];
    blk_sync();
    { const cf w1 = fft_opaque(w.wa); cf wp = w1; x[0] = buf[s1];
#pragma unroll
      for (int p = 1; p < 16; ++p) { x[p] = cmulc(buf[s1 + 272 * p], wp); wp = cmul(wp, w1); } }
    dft16<1>(x);
}
__device__ __forceinline__ float block_sum_512(float v, LAS float* red) {
    for (int o = 32; o > 0; o >>= 1) v += __shfl_xor(v, o);
    blk_sync();
    { const int t_ = lnd(threadIdx.x); if ((t_ & 63) == 0) red[t_ >> 6] = v; }
    blk_sync();
    return ((red[0] + red[1]) + (red[2] + red[3])) + ((red[4] + red[5]) + (red[6] + red[7]));
}
__device__ __forceinline__ cf w32_pow(int q) {
    const float C[16] = {1.0f, 0.98078528040323043f, 0.92387953251128674f, 0.83146961230254524f, 0.70710678118654752f, 0.55557023301960218f, 0.38268343236508977f, 0.19509032201612825f,
                         0.0f, -0.19509032201612825f, -0.38268343236508977f, -0.55557023301960218f, -0.70710678118654752f, -0.83146961230254524f, -0.92387953251128674f, -0.98078528040323043f};
    const float S[16] = {0.0f, 0.19509032201612825f, 0.38268343236508977f, 0.55557023301960218f, 0.70710678118654752f, 0.83146961230254524f, 0.92387953251128674f, 0.98078528040323043f,
                         1.0f, 0.98078528040323043f, 0.92387953251128674f, 0.83146961230254524f, 0.70710678118654752f, 0.55557023301960218f, 0.38268343236508977f, 0.19509032201612825f};
    return cf{C[q], -S[q]};
}
__device__ __forceinline__ cf hy_conv_lds(const LAS bf16_t* row, float w0, float w1, float w2, float bias, int n) {
    cf r; const int nm = n - (n > 0 ? 1 : 0);
    { const LAS bf16_t* p = row;       float um = bf2f(p[nm]), u0 = bf2f(p[n]), up = bf2f(p[n + 1]); um = n > 0 ? um : 0.f; up = n < SEQ - 1 ? up : 0.f; r.x = w0 * um + w1 * u0 + w2 * up + bias; }
    { const LAS bf16_t* p = row + SEQ; float um = bf2f(p[nm]), u0 = bf2f(p[n]), up = bf2f(p[n + 1]); um = n > 0 ? um : 0.f; up = n < SEQ - 1 ? up : 0.f; r.y = w0 * um + w1 * u0 + w2 * up + bias; }
    return r;
}
__device__ __forceinline__ void hyena_taps(int c, int o, const float* __restrict__ KT, float (&f)[16], int tid) {
    const int hf = tid >> 8, tl = fft_launder(tid & 255);
    const float* krow = KT + (size_t)(o * 2 * 1024 + c) * SEQ;
#pragma unroll
    for (int q = 0; q < 16; ++q) { const int n = tl + 256 * q; const int pos = hf ? SEQ - n : n; f[q] = (pos < SEQ) ? krow[hf * (1024 * SEQ) + pos] : 0.f; }
}
__device__ __forceinline__ void hyena_kspec(const float (&f)[16], cf (&K)[16], LAS unsigned char* lds, const FftTw& w, int tid) {
    const int hf = tid >> 8, t = tid & 255, s1 = t + (t >> 4);
    LAS cf* buf = (LAS cf*)(lds + FFT_BUF_OFF + hf * FFT_BUF_BYTES);
    LAS cf* obuf = (LAS cf*)(lds + FFT_BUF_OFF + (1 - hf) * FFT_BUF_BYTES);
    LAS float* red = (LAS float*)(lds + FFT_RED_OFF);
    float l1 = 0.f;
#pragma unroll
    for (int q = 0; q < 16; ++q) { l1 += fabsf(f[q]); buf[s1 + 272 * q] = cf{f[q], 0.f}; }
    l1 = block_sum_512(l1, red);
    const cf w8o = fft_opaque(w.w8);
#pragma unroll
    for (int q = 0; q < 16; ++q) { const float mine = buf[s1 + 272 * q].x, other = obuf[s1 + 272 * q].x; const float fw = hf ? other : mine, bw = hf ? mine : other;
        if (hf == 0) K[q] = cf{fw + bw, 0.f};
        else { const cf w8 = cmul(w8o, w32_pow(q)); const float d = fw - bw; K[q] = cf{d * w8.x, d * w8.y}; } }
    blk_sync();
    fft4096_fwd(K, t, buf, w);
    blk_sync();
    const float sc = 1.0f / ((l1 + EPS) * 8192.0f);
#pragma unroll
    for (int p = 0; p < 16; ++p) K[p] *= sc;
}
__device__ __forceinline__ void hyena_rows(int c, const bf16_t* __restrict__ ZT, u32x4 (&rowreg)[6], int tid) {
    const int tl = fft_launder(tid);
#pragma unroll
    for (int rw = 0; rw < 3; ++rw) { const bf16_t* src = ZT + (size_t)(rw * 1024 + c) * MROWS;
#pragma unroll
        for (int jj = 0; jj < 2; ++jj) rowreg[rw * 2 + jj] = *(const u32x4*)(src + (jj * 512 + tl) * 8); }
}
__device__ __forceinline__ void hyena_item(int c, const bf16_t* __restrict__ ZT, const float* __restrict__ KT, const float* __restrict__ cw, const float* __restrict__ cb,
                                           const float* __restrict__ hbias, float* __restrict__ YBT, cf* __restrict__ kscr  , const cf* __restrict__ kpre  ,
                                           int c_next  , u32x4 (&rowreg)[6]  , LAS unsigned char* lds) {
    int tid_ = threadIdx.x;
#ifndef EMU
    asm volatile("" : "+v"(tid_));
#endif
    const int tid = tid_, hf = tid >> 8, t = tid & 255;
    const FftTw w = fft_make_tw(t);
    LAS cf* buf = (LAS cf*)(lds + FFT_BUF_OFF + hf * FFT_BUF_BYTES);
    LAS cf* obuf = (LAS cf*)(lds + FFT_BUF_OFF + (1 - hf) * FFT_BUF_BYTES);
    LAS float* red = (LAS float*)(lds + FFT_RED_OFF);
    LAS bf16_t* urow = (LAS bf16_t*)(lds + FFT_UROW_OFF);
    LAS cf* z1 = (LAS cf*)(lds + FFT_Z1_OFF);
    const int s1 = t + (t >> 4);
    const cf W32_1 = cf{0.98078528040323043f, -0.19509032201612825f};
    float ftap[16];
    if (!kpre) hyena_taps(c, 0, KT, ftap, tid);
#pragma unroll
    for (int rw = 0; rw < 3; ++rw)
#pragma unroll
        for (int jj = 0; jj < 2; ++jj) *(LAS u32x4*)(urow + rw * 2 * SEQ + (jj * 512 + tid) * 8) = rowreg[rw * 2 + jj];
    blk_sync();
    {
        const float vw0 = cw[c], vw1 = cw[3072 + c], vw2 = cw[2 * 3072 + c], vbb = cb[c];
#pragma unroll 1
        for (int q = hf * 8; q < hf * 8 + 8; ++q) { const int n = t + 256 * q; z1[n] = hy_conv_lds(urow, vw0, vw1, vw2, vbb, n); }
    }
    blk_sync();
#pragma unroll
    for (int o = 0; o < 2; ++o) {
        cf K[16];
        if (kpre) { const int tk = fft_launder(tid);
#pragma unroll
            for (int p = 0; p < 16; ++p) K[p] = kpre[(size_t)o * (16 * 512) + p * 512 + tk]; }
        else { hyena_kspec(ftap, K, lds, w, tid); if (o == 0) hyena_taps(c, 1, KT, ftap, tid); }
        {
            cf tw = fft_opaque(w.w8);
#pragma unroll 1
            for (int q = 0; q < 16; ++q) { const cf xv = z1[t + 256 * q]; buf[s1 + 272 * q] = hf ? cmul(xv, tw) : xv; tw = cmul(tw, W32_1); }
        }
        cf s[16];
#pragma unroll
        for (int q = 0; q < 16; ++q) s[q] = buf[s1 + 272 * q];
        fft4096_fwd(s, t, buf, w);
#pragma unroll
        for (int p = 0; p < 16; ++p) s[p] = cmul(s[p], K[p]);
        if (o == 1 && c_next >= 0) hyena_rows(c_next, ZT, rowreg, tid);
        fft4096_inv(s, t, buf, w);
        { const cf w8o = fft_opaque(w.w8);
#pragma unroll
          for (int q = 0; q < 16; ++q) { cf v = s[DFT16_T(q)]; if (hf) v = cmulc(v, cmul(w8o, w32_pow(q))); buf[s1 + 272 * q] = v; } }
        blk_sync();
        {
            const int ch = (o + 1) * 1024 + c;
            const float w0 = cw[ch], w1 = cw[3072 + ch], w2 = cw[2 * 3072 + ch], bb = cb[ch], hb = hbias[o * 1024 + c];
            float* yb = YBT + (size_t)c * MLAT;
#pragma unroll 1
            for (int q = hf * 8; q < hf * 8 + 8; ++q) { const int n = t + 256 * q; const cf y = buf[s1 + 272 * q] + obuf[s1 + 272 * q];
                const cf xv = z1[n];
                const cf xm = hy_conv_lds(urow + (o + 1) * 2 * SEQ, w0, w1, w2, bb, n);
                const cf res = xm * (y + hb * xv);
                if (o == 0) z1[n] = res;
                else { yb[n] = res.x; yb[SEQ + n] = res.y; } }
        }
        blk_sync();
    }
}
__device__ __forceinline__ void fourier_rows(int cp, const bf16_t* __restrict__ UCST, u32x4 (&rowreg)[4], int tid) {
    const int tl = fft_launder(tid);
#pragma unroll
    for (int rw = 0; rw < 2; ++rw) { const bf16_t* src = UCST + (size_t)(rw * 1024 + cp) * MROWS;
#pragma unroll
        for (int jj = 0; jj < 2; ++jj) rowreg[rw * 2 + jj] = *(const u32x4*)(src + (jj * 512 + tl) * 8); }
}
__device__ __forceinline__ void fourier_item(int cp, const bf16_t* __restrict__ UCST, bf16_t* __restrict__ YAT, int cp_next, u32x4 (&rowreg)[4]  , LAS unsigned char* lds, const FftTw& w) {
    const int tid = lnd(threadIdx.x), hf = tid >> 8, t = tid & 255;
    LAS cf* buf = (LAS cf*)(lds + FFT_BUF_OFF + hf * FFT_BUF_BYTES);
    LAS bf16_t* urow = (LAS bf16_t*)(lds + FFT_UROW_OFF);
#pragma unroll
    for (int rw = 0; rw < 2; ++rw)
#pragma unroll
        for (int jj = 0; jj < 2; ++jj) *(LAS u32x4*)(urow + rw * 2 * SEQ + (jj * 512 + tid) * 8) = rowreg[rw * 2 + jj];
    blk_sync();
    if (cp_next >= 0) fourier_rows(cp_next, UCST, rowreg, tid);
    cf x[16];
    { const LAS bf16_t* uc = urow + hf * SEQ + t; const LAS bf16_t* us = urow + 2 * SEQ + hf * SEQ + t;
#pragma unroll
      for (int q = 0; q < 16; ++q) x[q] = cf{bf2f(uc[256 * q]), -bf2f(us[256 * q])}; }
    fft4096_fwd(x, t, buf, w);
    blk_sync();
    LAS float* fb = (LAS float*)buf;
    const int f0 = (t >> 4) + 16 * (t & 15);
#pragma unroll
    for (int p = 0; p < 16; ++p) fb[f0 + 256 * p] = x[DFT16_T(p)].x * (1.0f / 1024.0f);
    blk_sync();
    { bf16_t* ya = YAT + (size_t)cp * MLAT + hf * SEQ;
#pragma unroll
      for (int jj = 0; jj < 2; ++jj) { const int n8 = (jj * 256 + fft_launder(t)) * 8; const f32x4 v0 = *(const LAS f32x4*)(fb + n8), v1 = *(const LAS f32x4*)(fb + n8 + 4);
          u32x4 o; o.x = (unsigned)f2bf(v0[0]) | ((unsigned)f2bf(v0[1]) << 16); o.y = (unsigned)f2bf(v0[2]) | ((unsigned)f2bf(v0[3]) << 16); o.z = (unsigned)f2bf(v1[0]) | ((unsigned)f2bf(v1[1]) << 16); o.w = (unsigned)f2bf(v1[2]) | ((unsigned)f2bf(v1[3]) << 16);
          *(u32x4*)(ya + n8) = o; } }
    blk_sync();
}
typedef short bf16x8 __attribute__((ext_vector_type(8)));
constexpr int NCHUNK = SEQP / 64;
constexpr int SC_PS = 72;
__device__ __forceinline__ int scan_chunk_map(int j, int dir) { return dir ? (j < 4 ? 3 - j : 71 - j) : j; }
__device__ __forceinline__ int ml_tok_row(int b, int p) { if (p < CTXL) return MLAT + b * CTXL + p; const int pp = p - CTXL; return b * SEQ + (pp & 63) * 64 + (pp >> 6); }
__device__ __forceinline__ int gla_tok_row(int b, int p) { return p < CTXL ? MLAT + b * CTXL + p : b * SEQ + p - CTXL; }
__device__ __forceinline__ unsigned pack_bf2(float lo, float hi) { return (unsigned)f2bf(lo) | ((unsigned)f2bf(hi) << 16); }

__device__ __forceinline__ void gate_scan_item(int seq, const float* __restrict__ ZG, const float* __restrict__ gate_b, float* __restrict__ LI, float* __restrict__ BG, float* __restrict__ MG, LAS unsigned char* lds) {
    const int tid = lnd(threadIdx.x), b = seq >> 3, h = (seq >> 1) & 3, dir = seq & 1;
    LAS float* tot = (LAS float*)lds; LAS float* mx = tot + 512;
    float li[9], bg[9]; float run = 0.f;
    const float bi = gate_b[dir * 8 + h], bf = gate_b[dir * 8 + 4 + h];
#pragma unroll
    for (int i = 0; i < 9; ++i) { const int p = tid * 9 + i; li[i] = 0.f; bg[i] = 0.f;
        if (p < SEQP) { const int pp = dir ? (p < CTXL ? CTXL - 1 - p : CTXL + SEQ - 1 - (p - CTXL)) : p; const size_t r = ml_tok_row(b, pp);
            li[i] = ZG[r * 256 + dir * 8 + h] + bi; run += logsigmoid_f(ZG[r * 256 + dir * 8 + 4 + h] + bf); bg[i] = run; } }
    const int lane = tid & 63, wv = tid >> 6;
    float inc = run;
#pragma unroll
    for (int d = 1; d < 64; d <<= 1) { const float o = __shfl_up(inc, d); if (lane >= d) inc += o; }
    if (lane == 63) tot[wv] = inc;
    blk_sync();
    float pre = inc - run;
    for (int u = 0; u < wv; ++u) pre += tot[u];
    float m = -3.0e38f;
#pragma unroll
    for (int i = 0; i < 9; ++i) { bg[i] += pre; const int p = tid * 9 + i; if (p < SEQP) m = fmaxf(m, li[i] - bg[i]); }
    float minc = m;
#pragma unroll
    for (int d = 1; d < 64; d <<= 1) { const float o = __shfl_up(minc, d); if (lane >= d) minc = fmaxf(minc, o); }
    if (lane == 63) mx[wv] = minc;
    blk_sync();
    float pm = 0.f;
    { const float ex = __shfl_up(minc, 1); if (lane >= 1) pm = fmaxf(pm, ex); }
    for (int u = 0; u < wv; ++u) pm = fmaxf(pm, mx[u]);
#pragma unroll
    for (int i = 0; i < 9; ++i) { const int p = tid * 9 + i; if (p < SEQP) { pm = fmaxf(pm, li[i] - bg[i]); LI[seq * SEQP + p] = li[i]; BG[seq * SEQP + p] = bg[i]; MG[seq * SEQP + p] = bg[i] + pm; } }
    blk_sync();
}

constexpr int S1_PQ = 264;
constexpr int S1_QB = 0, S1_KB = S1_QB + 64 * S1_PQ * 2, S1_KT = S1_KB + 64 * S1_PQ * 2, S1_SB = S1_KT + 256 * SC_PS * 2, S1_SC = S1_SB + 64 * SC_PS * 2, S1_LA = S1_SC + 2048, S1_LDS_BYTES = S1_LA + 64 * 128 * 4;
__device__ __forceinline__ void s1_copy_out(const LAS bf16_t* src, bf16_t* dst, int rows) {
    for (int e = lnd(threadIdx.x); e < rows * 8; e += 512) { const int r = e >> 3, c = e & 7; *(u32x4*)(dst + (size_t)r * 64 + c * 8) = *(const LAS u32x4*)(src + r * SC_PS + c * 8); }
}
template <bool ML> __device__ __forceinline__ void s1_vt(const bf16_t* __restrict__ Z, int zc, int b, int h, int jo, bf16_t* __restrict__ vt, LAS unsigned char* lds) {
    LAS bf16_t* T = (LAS bf16_t*)(lds + S1_QB);
    for (int e = lnd(threadIdx.x); e < 64 * 64; e += 512) { const int row = e >> 6, c4 = (e & 63) * 4; const int p = jo * 64 + row; const size_t r = ML ? ml_tok_row(b, p) : gla_tok_row(b, p);
        const u32x2 v = *(const u32x2*)(Z + r * NP + zc + h * 256 + c4);
        T[(c4 + 0) * SC_PS + row] = (bf16_t)(v.x & 0xffff); T[(c4 + 1) * SC_PS + row] = (bf16_t)(v.x >> 16); T[(c4 + 2) * SC_PS + row] = (bf16_t)(v.y & 0xffff); T[(c4 + 3) * SC_PS + row] = (bf16_t)(v.y >> 16); }
    blk_sync();
    s1_copy_out(T, vt, 256);
    blk_sync();
}
template <int KSTEPS> __device__ __forceinline__ void s1_qk(const LAS bf16_t* Qb, const LAS bf16_t* Kb, int w, int r, int q, f32x4 (&acc)[2]) {
#pragma unroll
    for (int ti = 0; ti < 2; ++ti) { const int id = 2 * w + ti, mt = id >> 2, nt = id & 3; acc[ti] = (f32x4){0.f, 0.f, 0.f, 0.f};
#pragma unroll
        for (int kk = 0; kk < KSTEPS; ++kk) { const bf16x8 a = *(const LAS bf16x8*)(Qb + (16 * mt + r) * S1_PQ + 32 * kk + 8 * q), bb = *(const LAS bf16x8*)(Kb + (16 * nt + r) * S1_PQ + 32 * kk + 8 * q);
            acc[ti] = __builtin_amdgcn_mfma_f32_16x16x32_bf16(a, bb, acc[ti], 0, 0, 0); } }
}
__device__ __forceinline__ void ml_s1_rows(int seq, int jo, const bf16_t* __restrict__ Z, u32x2 (&rq)[10], u32x2 (&rk)[10], int tid) {
    const int b = seq >> 3, h = (seq >> 1) & 3, hc = h * 256 + (tid & 63) * 4, row0 = (tid >> 6) * 8;
#pragma unroll
    for (int i = 0; i < 10; ++i) { const int pp = jo * 64 + row0 + i - 1;
        const int pc = pp < 0 ? 0 : (pp > SEQP - 1 ? SEQP - 1 : pp); const size_t tr = ml_tok_row(b, pc);
        rq[i] = *(const u32x2*)(Z + tr * NP + ZC_CQ + hc); rk[i] = *(const u32x2*)(Z + tr * NP + ZC_CK + hc); }
}
__device__ __forceinline__ void ml_s1_item(int seq, int jo, const float* __restrict__ cw  , const float* __restrict__ cb  , const bf16_t* __restrict__ Z, const float* __restrict__ LI, const float* __restrict__ BG, const float* __restrict__ MG,
                                           bf16_t* __restrict__ SP, bf16_t* __restrict__ QS, bf16_t* __restrict__ KST, float* __restrict__ DEC, float* __restrict__ CL, bf16_t* __restrict__ VT,
                                           int it_next  , u32x2 (&rq)[10], u32x2 (&rk)[10]  , LAS unsigned char* lds) {
    const int tid = lnd(threadIdx.x), w = tid >> 6, lane = tid & 63, r = lane & 15, q = lane >> 4;
    const int b = seq >> 3, h = (seq >> 1) & 3, dir = seq & 1, js = scan_chunk_map(jo, dir);
    LAS bf16_t* Qb = (LAS bf16_t*)(lds + S1_QB); LAS bf16_t* Kb = (LAS bf16_t*)(lds + S1_KB); LAS bf16_t* KT = (LAS bf16_t*)(lds + S1_KT); LAS bf16_t* Sb = (LAS bf16_t*)(lds + S1_SB);
    LAS float* at = (LAS float*)(lds + S1_SC); LAS float* as = at + 64; LAS float* wprev = at + 128; LAS float* wstate = at + 192;
    const size_t item = (size_t)seq * NCHUNK + jo;
    const int c4 = (tid & 63) * 4, hc = h * 256 + c4;
    const f32x4 wq0 = *(const f32x4*)(cw + hc), wq1 = *(const f32x4*)(cw + 1024 + hc), wq2 = *(const f32x4*)(cw + 2048 + hc), bq = *(const f32x4*)(cb + hc);
    const f32x4 wk0 = *(const f32x4*)(cw + 3072 + hc), wk1 = *(const f32x4*)(cw + 4096 + hc), wk2 = *(const f32x4*)(cw + 5120 + hc), bk = *(const f32x4*)(cb + 1024 + hc);
    const int row0 = (tid >> 6) * 8;
    if (tid < 64) {
        const int t = tid, ps = 64 * js + (dir ? 63 - t : t);
        const float* li = LI + seq * SEQP; const float* bg = BG + seq * SEQP; const float* mg = MG + seq * SEQP;
        const float Bt = bg[ps], Mt = mg[ps], lit = li[ps];
        const float Bs0 = js > 0 ? bg[64 * js - 1] : 0.f, Ms0 = js > 0 ? mg[64 * js - 1] : 0.f, Be = bg[64 * js + 63], Me = mg[64 * js + 63];
        at[t] = Bt - Mt; as[t] = lit - Bt; wprev[t] = fexp(Bt - Bs0 + Ms0 - Mt); wstate[t] = fexp(Be - Bt + lit - Me);
        CL[item * 64 + t] = fexp(-Mt);
        const float decay = fexp(Be - Bs0 + Ms0 - Me);
#pragma unroll
        for (int i = 0; i < 4; ++i) DEC[item * 256 + t * 4 + i] = decay;
    }
    blk_sync();
#pragma unroll
    for (int i = 0; i < 8; ++i) { const int row = row0 + i, pp = jo * 64 + row;
        const bool hasm = (pp != 0 && pp != CTXL), hasp = (pp != CTXL - 1 && pp != SEQP - 1);
        const float fm = hasm ? 1.f : 0.f, fp = hasp ? 1.f : 0.f;
        f32x4 qv, kv;
        { const u32x2 a = rq[i], c0 = rq[i + 1], d = rq[i + 2];
          const float am[4] = {__uint_as_float(a.x << 16), __uint_as_float(a.x & 0xffff0000u), __uint_as_float(a.y << 16), __uint_as_float(a.y & 0xffff0000u)};
          const float a0[4] = {__uint_as_float(c0.x << 16), __uint_as_float(c0.x & 0xffff0000u), __uint_as_float(c0.y << 16), __uint_as_float(c0.y & 0xffff0000u)};
          const float ap[4] = {__uint_as_float(d.x << 16), __uint_as_float(d.x & 0xffff0000u), __uint_as_float(d.y << 16), __uint_as_float(d.y & 0xffff0000u)};
#pragma unroll
          for (int j = 0; j < 4; ++j) qv[j] = silu_f(wq0[j] * am[j] * fm + wq1[j] * a0[j] + wq2[j] * ap[j] * fp + bq[j]); }
        { const u32x2 a = rk[i], c0 = rk[i + 1], d = rk[i + 2];
          const float am[4] = {__uint_as_float(a.x << 16), __uint_as_float(a.x & 0xffff0000u), __uint_as_float(a.y << 16), __uint_as_float(a.y & 0xffff0000u)};
          const float a0[4] = {__uint_as_float(c0.x << 16), __uint_as_float(c0.x & 0xffff0000u), __uint_as_float(c0.y << 16), __uint_as_float(c0.y & 0xffff0000u)};
          const float ap[4] = {__uint_as_float(d.x << 16), __uint_as_float(d.x & 0xffff0000u), __uint_as_float(d.y << 16), __uint_as_float(d.y & 0xffff0000u)};
#pragma unroll
          for (int j = 0; j < 4; ++j) kv[j] = silu_f(wk0[j] * am[j] * fm + wk1[j] * a0[j] + wk2[j] * ap[j] * fp + bk[j]) * 0.0625f; }
        u32x2 o; o.x = pack_bf2(qv[0], qv[1]); o.y = pack_bf2(qv[2], qv[3]); *(LAS u32x2*)(Qb + row * S1_PQ + c4) = o;
        o.x = pack_bf2(kv[0], kv[1]); o.y = pack_bf2(kv[2], kv[3]); *(LAS u32x2*)(Kb + row * S1_PQ + c4) = o;
        const float wp = wprev[row], ws = wstate[row];
        o.x = pack_bf2(qv[0] * wp, qv[1] * wp); o.y = pack_bf2(qv[2] * wp, qv[3] * wp); *(u32x2*)(QS + (item * 64 + row) * 256 + c4) = o;
#pragma unroll
        for (int j = 0; j < 4; ++j) KT[(c4 + j) * SC_PS + row] = f2bf(kv[j] * ws); }
    if (it_next >= 0) ml_s1_rows(it_next / NCHUNK, it_next % NCHUNK, Z, rq, rk, tid);
    blk_sync();
    f32x4 acc[2];
    s1_qk<8>(Qb, Kb, w, r, q, acc);
#pragma unroll
    for (int ti = 0; ti < 2; ++ti) { const int id = 2 * w + ti, mt = id >> 2, nt = id & 3, s = 16 * nt + r;
#pragma unroll
        for (int i = 0; i < 4; ++i) { const int t = 16 * mt + 4 * q + i; const bool valid = dir ? (s >= t) : (s <= t);
            Sb[t * SC_PS + s] = f2bf(valid ? acc[ti][i] * fexp(at[t] + as[s]) : 0.f); } }
    blk_sync();
    s1_copy_out(Sb, SP + item * 4096, 64);
    s1_copy_out(KT, KST + item * 256 * 64, 256);
    blk_sync();
    if (dir == 0) s1_vt<true>(Z, ZC_CV, b, h, jo, VT + ((size_t)(b * 4 + h) * NCHUNK + jo) * 256 * 64, lds);
}
__device__ __forceinline__ void gla_s1_item(int seq, int jo, const bf16_t* __restrict__ Z, const float* __restrict__ ZG, const float* __restrict__ w2, const float* __restrict__ b2,
                                            bf16_t* __restrict__ SP, bf16_t* __restrict__ QS, bf16_t* __restrict__ KST, float* __restrict__ DEC, bf16_t* __restrict__ VT, LAS unsigned char* lds) {
    const int tid = lnd(threadIdx.x), w = tid >> 6, lane = tid & 63, r = lane & 15, q = lane >> 4;
    const int b = seq >> 3, h = (seq >> 1) & 3, dir = seq & 1;
    LAS bf16_t* Qb = (LAS bf16_t*)(lds + S1_QB); LAS bf16_t* Kb = (LAS bf16_t*)(lds + S1_KB); LAS bf16_t* KT = (LAS bf16_t*)(lds + S1_KT); LAS bf16_t* Sb = (LAS bf16_t*)(lds + S1_SB);
    LAS float* LA = (LAS float*)(lds + S1_LA);
    LAS float* blast = (LAS float*)(lds + S1_SC);
    LAS float* a16 = (LAS float*)(lds + S1_KT);
    const size_t item = (size_t)seq * NCHUNK + jo;
    u32x2 pq[4], pk[4];
#pragma unroll
    for (int i = 0; i < 4; ++i) { const int e = i * 512 + tid, row = e >> 5, c4 = (e & 31) * 4; const size_t tr = gla_tok_row(b, jo * 64 + row);
        pq[i] = *(const u32x2*)(Z + tr * NP + ZC_DQ + h * 128 + c4); pk[i] = *(const u32x2*)(Z + tr * NP + ZC_DK + h * 128 + c4); }
    for (int e = tid; e < 64 * 16; e += 512) { const int t = e >> 4, rr = e & 15; const size_t tr = gla_tok_row(b, jo * 64 + t); a16[e] = ZG[tr * 256 + 16 + dir * 16 + rr]; }
    blk_sync();
    {
        const int k = tid & 127, tg = tid >> 7; float wr[16];
#pragma unroll
        for (int rr = 0; rr < 16; ++rr) wr[rr] = w2[(dir * 16 + rr) * 512 + h * 128 + k];
        const float bb = b2[dir * 512 + h * 128 + k];
        for (int t = tg * 16; t < tg * 16 + 16; ++t) { float x = bb;
#pragma unroll
            for (int rr = 0; rr < 16; ++rr) x += a16[t * 16 + rr] * wr[rr];
            LA[t * 128 + k] = logsigmoid_fast(x) * (1.0f / 16.0f); }
    }
    blk_sync();
    {
        const int k = tid & 127, sg = tid >> 7; float run = 0.f; float vals[16];
#pragma unroll
        for (int i = 0; i < 16; ++i) { const int si = sg * 16 + i, t = dir ? 63 - si : si; run += LA[t * 128 + k]; vals[i] = run; }
        LAS float* segs = blast + 128;
        if (sg < 3) segs[sg * 128 + k] = run;
        blk_sync();
        float off = 0.f;
#pragma unroll
        for (int u = 0; u < 3; ++u) off += (u < sg) ? segs[u * 128 + k] : 0.f;
#pragma unroll
        for (int i = 0; i < 16; ++i) { const int si = sg * 16 + i, t = dir ? 63 - si : si; LA[t * 128 + k] = vals[i] + off; }
        if (sg == 3) { const float tot = run + off; blast[k] = tot; DEC[item * 128 + k] = fexp(tot); }
    }
    blk_sync();
    const float qsc = 0.08838834764831845f;
#pragma unroll
    for (int i = 0; i < 4; ++i) { const int e = i * 512 + tid, row = e >> 5, c4 = (e & 31) * 4;
        const u32x2 qz = pq[i], kz = pk[i];
        float qv[4] = {__uint_as_float(qz.x << 16), __uint_as_float(qz.x & 0xffff0000u), __uint_as_float(qz.y << 16), __uint_as_float(qz.y & 0xffff0000u)};
        float kv[4] = {__uint_as_float(kz.x << 16), __uint_as_float(kz.x & 0xffff0000u), __uint_as_float(kz.y << 16), __uint_as_float(kz.y & 0xffff0000u)};
        float qd[4], q2[4], kd[4];
#pragma unroll
        for (int j = 0; j < 4; ++j) { const float bc = LA[row * 128 + c4 + j], bl = blast[c4 + j]; qd[j] = qv[j] * qsc * fexp(bc); q2[j] = qv[j] * qsc * fexp(bc - bl); kd[j] = kv[j] * fexp(bl - bc); }
        u32x2 o; o.x = pack_bf2(qd[0], qd[1]); o.y = pack_bf2(qd[2], qd[3]); *(u32x2*)(QS + (item * 64 + row) * 128 + c4) = o;
        o.x = pack_bf2(q2[0], q2[1]); o.y = pack_bf2(q2[2], q2[3]); *(LAS u32x2*)(Qb + row * S1_PQ + c4) = o;
        o.x = pack_bf2(kd[0], kd[1]); o.y = pack_bf2(kd[2], kd[3]); *(LAS u32x2*)(Kb + row * S1_PQ + c4) = o;
#pragma unroll
        for (int j = 0; j < 4; ++j) KT[(c4 + j) * SC_PS + row] = f2bf(kd[j]); }
    blk_sync();
    f32x4 acc[2];
    s1_qk<4>(Qb, Kb, w, r, q, acc);
#pragma unroll
    for (int ti = 0; ti < 2; ++ti) { const int id = 2 * w + ti, mt = id >> 2, nt = id & 3, s = 16 * nt + r;
#pragma unroll
        for (int i = 0; i < 4; ++i) { const int t = 16 * mt + 4 * q + i; const bool valid = dir ? (s >= t) : (s <= t); Sb[t * SC_PS + s] = f2bf(valid ? acc[ti][i] : 0.f); } }
    blk_sync();
    s1_copy_out(Sb, SP + item * 4096, 64);
    s1_copy_out(KT, KST + item * 128 * 64, 128);
    blk_sync();
    if (dir == 0) s1_vt<false>(Z, ZC_DV, b, h, jo, VT + ((size_t)(b * 4 + h) * NCHUNK + jo) * 256 * 64, lds);
}

__device__ __forceinline__ void lds_barrier() {
#ifndef EMU
    asm volatile("s_waitcnt lgkmcnt(0)\n\ts_barrier" ::: "memory");
#else
    __syncthreads();
#endif
}
template <int MODE> struct S2Cfg { static constexpr int DKK = MODE ? 128 : 256, NT = MODE ? 2 : 3, NSW = DKK / 32, PQ = DKK + 8;
    static constexpr int SPB = 0, QSB = SPB + 64 * SC_PS * 2, KSB = QSB + 64 * PQ * 2, VTB = KSB + DKK * SC_PS * 2, CBB = VTB + 32 * SC_PS * 2, DCB = CBB + NSW * NT * 64 * 16, CLB = DCB + DKK * 4, DNB = CLB + 256, LDS_BYTES = DNB + 256; };
template <int MODE> __device__ __forceinline__ void scan_item(int seq, int slice, const bf16_t* __restrict__ SP, const bf16_t* __restrict__ QS, const bf16_t* __restrict__ KST, const bf16_t* __restrict__ VT,
                                                              const float* __restrict__ DEC, const float* __restrict__ CL, float* __restrict__ OUT, LAS unsigned char* lds) {
    typedef S2Cfg<MODE> C;
    constexpr int DKK = C::DKK, NT = C::NT, NSW = C::NSW, PQ = C::PQ;
    const int tid = lnd(threadIdx.x), w = tid >> 6, lane = tid & 63, r = lane & 15, q = lane >> 4;
    const int b = seq >> 3, h = (seq >> 1) & 3, dir = seq & 1;
    LAS bf16_t* SPb = (LAS bf16_t*)(lds + C::SPB); LAS bf16_t* QSb = (LAS bf16_t*)(lds + C::QSB); LAS bf16_t* KSb = (LAS bf16_t*)(lds + C::KSB); LAS bf16_t* VTb = (LAS bf16_t*)(lds + C::VTB);
    LAS u32x4* CB = (LAS u32x4*)(lds + C::CBB); LAS float* dec = (LAS float*)(lds + C::DCB); LAS float* clamp = (LAS float*)(lds + C::CLB); LAS float* denb = (LAS float*)(lds + C::DNB);
    constexpr int NMT = DKK / 64;
    const bool outw = (w & 1) == 0; const int ow = w >> 1;
    f32x4 St[NMT][NT];
#pragma unroll
    for (int mi = 0; mi < NMT; ++mi)
#pragma unroll
        for (int nt = 0; nt < NT; ++nt) St[mi][nt] = (f32x4){0.f, 0.f, 0.f, 0.f};
    bf16x8 augf;
#pragma unroll
    for (int j = 0; j < 8; ++j) augf[j] = (short)(r == 0 ? 0x3F80 : 0);
    u32x4 rSP, rQS[DKK / 64], rKS[DKK / 64], rVT = {0u, 0u, 0u, 0u}; float rDEC = 0.f, rCL = 0.f;
    unsigned oQS[DKK / 64], oKS[DKK / 64];
#pragma unroll
    for (int i = 0; i < DKK / 64; ++i) { const int e = i * 512 + tid; oQS[i] = (unsigned)(((e / (DKK / 8)) * DKK + (e % (DKK / 8)) * 8) * 2); oKS[i] = (unsigned)(((e >> 3) * 64 + (e & 7) * 8) * 2); }
    const unsigned oSP = (unsigned)(((tid >> 3) * 64 + (tid & 7) * 8) * 2), oVT = (unsigned)((((slice * 32 + (tid >> 3)) * 64) + (tid & 7) * 8) * 2);
    const char* const vtb = (const char*)VT + (size_t)(b * 4 + h) * NCHUNK * 256 * 64 * 2;
#define S2_PREFETCH(JS) do { const int jo_ = scan_chunk_map((JS), dir); const unsigned item_ = (unsigned)(seq * NCHUNK + jo_); \
        const char* sp_ = (const char*)SP + (size_t)item_ * 8192; const char* qs_ = (const char*)QS + (size_t)item_ * (64 * DKK * 2); const char* ks_ = (const char*)KST + (size_t)item_ * (DKK * 64 * 2); \
        rSP = *(const u32x4*)(sp_ + oSP); \
        _Pragma("unroll") for (int i = 0; i < DKK / 64; ++i) { rQS[i] = *(const u32x4*)(qs_ + oQS[i]); rKS[i] = *(const u32x4*)(ks_ + oKS[i]); } \
        if (tid < 256) rVT = *(const u32x4*)(vtb + (size_t)jo_ * (256 * 64 * 2) + oVT); \
        if (tid < DKK) rDEC = DEC[item_ * DKK + tid]; \
        if (MODE == 0 && tid < 64) rCL = CL[item_ * 64 + tid]; } while (0)
    S2_PREFETCH(0);
#pragma unroll 1
    for (int js = 0; js < NCHUNK; ++js) {
        const int jo = scan_chunk_map(js, dir);
        lds_barrier();
        *(LAS u32x4*)(SPb + (tid >> 3) * SC_PS + (tid & 7) * 8) = rSP;
#pragma unroll
        for (int i = 0; i < DKK / 64; ++i) { const int e = i * 512 + tid; *(LAS u32x4*)(QSb + (e / (DKK / 8)) * PQ + (e % (DKK / 8)) * 8) = rQS[i]; *(LAS u32x4*)(KSb + (e >> 3) * SC_PS + (e & 7) * 8) = rKS[i]; }
        if (tid < 256) *(LAS u32x4*)(VTb + (tid >> 3) * SC_PS + (tid & 7) * 8) = rVT;
        if (tid < DKK) dec[tid] = rDEC;
        if (MODE == 0 && tid < 64) clamp[tid] = rCL;
        if (!outw) {
#pragma unroll
            for (int kl = 0; kl < NMT / 2; ++kl)
#pragma unroll
                for (int nt = 0; nt < NT; ++nt) { u32x4 f; f.x = pack_bf2(St[2 * kl][nt][0], St[2 * kl][nt][1]); f.y = pack_bf2(St[2 * kl][nt][2], St[2 * kl][nt][3]);
                    f.z = pack_bf2(St[2 * kl + 1][nt][0], St[2 * kl + 1][nt][1]); f.w = pack_bf2(St[2 * kl + 1][nt][2], St[2 * kl + 1][nt][3]);
                    CB[((ow * (NMT / 2) + kl) * NT + nt) * 64 + lane] = f; }
        }
        lds_barrier();
        if (js + 1 < NCHUNK) S2_PREFETCH(js + 1);
        if (outw) {
            f32x4 oacc[NT];
#pragma unroll
            for (int nt = 0; nt < NT; ++nt) oacc[nt] = (f32x4){0.f, 0.f, 0.f, 0.f};
#pragma unroll
            for (int kk = 0; kk < NSW; ++kk) { const LAS bf16_t* ap = QSb + (16 * ow + r) * PQ + 32 * kk + 4 * q;
                const u32x2 a0 = *(const LAS u32x2*)ap, a1 = *(const LAS u32x2*)(ap + 16); u32x4 au; au.x = a0.x; au.y = a0.y; au.z = a1.x; au.w = a1.y;
#pragma unroll
                for (int nt = 0; nt < NT; ++nt) { const u32x4 bu = CB[(kk * NT + nt) * 64 + lane];
                    oacc[nt] = __builtin_amdgcn_mfma_f32_16x16x32_bf16(__builtin_bit_cast(bf16x8, au), __builtin_bit_cast(bf16x8, bu), oacc[nt], 0, 0, 0); } }
#pragma unroll
            for (int ks = 0; ks < 2; ++ks) { const bf16x8 a = *(const LAS bf16x8*)(SPb + (16 * ow + r) * SC_PS + 32 * ks + 8 * q);
#pragma unroll
                for (int nt = 0; nt < NT; ++nt) { const bf16x8 bb = (MODE == 0 && nt == 2) ? augf : *(const LAS bf16x8*)(VTb + (16 * nt + r) * SC_PS + 32 * ks + 8 * q);
                    oacc[nt] = __builtin_amdgcn_mfma_f32_16x16x32_bf16(a, bb, oacc[nt], 0, 0, 0); } }
            const bool isctx = jo < 4;
            const int rowA = isctx ? MLAT + b * CTXL + jo * 64 : (MODE ? b * SEQ + (jo - 4) * 64 : b * SEQ + (jo - 4));
            const int tmul = (MODE == 0 && !isctx) ? 64 : 1;
            float* const obase = OUT + ((size_t)dir * MROWS + rowA) * 1024 + h * 256 + slice * 32;
#pragma unroll
            for (int i = 0; i < 4; ++i) { const int t = 16 * ow + 4 * q + i;
                float sc = 1.0f;
                if (MODE == 0) { const float den = __shfl(oacc[NT - 1][i], lane & 48); sc = frcp(fmaxf(fabsf(den), clamp[t])); }
#pragma unroll
                for (int nt = 0; nt < 2; ++nt) obase[(unsigned)(t * tmul * 1024 + 16 * nt + r)] = oacc[nt][i] * sc; }
        } else {
#pragma unroll
            for (int mi = 0; mi < NMT; ++mi) { const int mtile = ow * NMT + mi;
                bf16x8 a[2];
#pragma unroll
                for (int ks = 0; ks < 2; ++ks) a[ks] = *(const LAS bf16x8*)(KSb + (16 * mtile + r) * SC_PS + 32 * ks + 8 * q);
#pragma unroll
                for (int nt = 0; nt < NT; ++nt) {
#pragma unroll
                    for (int i = 0; i < 4; ++i) St[mi][nt][i] *= dec[16 * mtile + 4 * q + i];
#pragma unroll
                    for (int ks = 0; ks < 2; ++ks) { const bf16x8 bb = (MODE == 0 && nt == 2) ? augf : *(const LAS bf16x8*)(VTb + (16 * nt + r) * SC_PS + 32 * ks + 8 * q);
                        St[mi][nt] = __builtin_amdgcn_mfma_f32_16x16x32_bf16(a[ks], bb, St[mi][nt], 0, 0, 0); } } }
        }
    }
    blk_sync();
#undef S2_PREFETCH
}
#define XB_TMO      128
#define XB_XCNT(j)  (256  + 64 * (j))
#define XB_XSUB(j)  (1280 + 64 * (j))
#define XB_XGEN(j)  (2304 + 64 * (j))
#define XB_TOP      3328
#define XB_TOPGEN   3392
#define XCD_BAR_WORDS 3456
#define XB_SPIN_CAP (1u << 18)

__device__ __forceinline__ unsigned xb_ld(unsigned* p)              { return __hip_atomic_load(p, __ATOMIC_RELAXED, __HIP_MEMORY_SCOPE_AGENT); }
__device__ __forceinline__ unsigned xb_add(unsigned* p, unsigned v) { return __hip_atomic_fetch_add(p, v, __ATOMIC_RELAXED, __HIP_MEMORY_SCOPE_AGENT); }
__device__ __forceinline__ unsigned xb_xcc_id() { return (unsigned)__builtin_amdgcn_s_getreg((3 << 11) | 20) & 0xFu; }
#define XB_SPIN(cond, bar) do { unsigned _sp = 0; while (cond) { __builtin_amdgcn_s_sleep(1); \
    if ((++_sp & 255u) == 0u) { if (xb_ld(&(bar)[XB_TMO])) break; if (_sp > XB_SPIN_CAP) { atomicAdd(&(bar)[XB_TMO], 1u); break; } } } } while (0)

struct XcdBarrier {
    unsigned* bar; unsigned x;
    volatile LAS unsigned* st;
};

__device__ __forceinline__ XcdBarrier xcd_barrier_post(unsigned* bar, volatile LAS unsigned* st) {
    XcdBarrier b; b.bar = bar; b.x = xb_xcc_id(); b.st = st;
    if (threadIdx.x == 0) (void)xb_add(&bar[XB_XCNT(b.x)], 1u);
    return b;
}
__device__ __forceinline__ void xcd_barrier_complete(unsigned* bar, unsigned x, unsigned& nloc, unsigned& nx) {
    const unsigned G = gridDim.x * gridDim.y * gridDim.z;
    unsigned sum, cnt, mine, sp = 0u;
    for (;;) {
        sum = 0u; cnt = 0u; mine = 0u;
#pragma unroll
        for (unsigned j = 0; j < 16; ++j) { const unsigned c = xb_ld(&bar[XB_XCNT(j)]); sum += c; cnt += (c > 0u) ? 1u : 0u; mine = (j == x) ? c : mine; }
        if (sum == G) break;
        __builtin_amdgcn_s_sleep(1);
        if ((++sp & 255u) == 0u) { if (xb_ld(&bar[XB_TMO])) break; if (sp > XB_SPIN_CAP) { atomicAdd(&bar[XB_TMO], 1u); break; } }
    }
    nloc = mine > 0u ? mine : 1u; nx = cnt > 0u ? cnt : 1u;
}

__device__ __forceinline__ void xcd_barrier(const XcdBarrier& b) {
    asm volatile("s_waitcnt vmcnt(0)" ::: "memory");
    __syncthreads();
    if (threadIdx.x == 0) {
        unsigned* bar = b.bar;
        __builtin_amdgcn_s_waitcnt(0);
        unsigned nloc = b.st[0], nx = b.st[1];
        if (nloc == 0u) { xcd_barrier_complete(bar, b.x, nloc, nx); b.st[0] = nloc; b.st[1] = nx; }
        const unsigned old = xb_add(&bar[XB_XSUB(b.x)], 1u);
        const unsigned gen = old / nloc;
        if (old + 1u == (gen + 1u) * nloc) {
            __builtin_amdgcn_fence(__ATOMIC_RELEASE, "agent");
            asm volatile("s_waitcnt vmcnt(0)" ::: "memory");
            const unsigned og = xb_add(&bar[XB_TOP], 1u);
            const unsigned tg = og / nx;
            if (og + 1u == (tg + 1u) * nx) xb_add(&bar[XB_TOPGEN], 1u);
            else XB_SPIN(xb_ld(&bar[XB_TOPGEN]) == tg, bar);
            __builtin_amdgcn_fence(__ATOMIC_ACQUIRE, "agent");
            xb_add(&bar[XB_XGEN(b.x)], 1u);
            asm volatile("s_waitcnt vmcnt(0)" ::: "memory");
        } else {
            XB_SPIN(xb_ld(&bar[XB_XGEN(b.x)]) == gen, bar);
            __builtin_amdgcn_fence(__ATOMIC_ACQUIRE, "agent");
            asm volatile("s_waitcnt vmcnt(0)" ::: "memory");
        }
    }
    __syncthreads();
}
#define MP_FIELDS(X) \
X(const float*, x) X(const float*, c) X(const float*, ctx) X(const float*, c_ctx) X(const float*, ada_w) X(const float*, ada_b) X(const float*, norm_g) X(const float*, w_in) X(const float*, fnet_w) X(const float*, hy_conv_w) X(const float*, hy_conv_b) X(const float*, hy_f_w1) X(const float*, hy_f_b1) X(const float*, hy_f_w2) X(const float*, hy_f_b2) X(const float*, hy_f_w3) X(const float*, hy_f_freq) X(const float*, hy_bias) X(const float*, ml_conv_w) X(const float*, ml_conv_b) X(const float*, ml_gate_b) X(const float*, gla_w2) X(const float*, gla_b2) X(const float*, gla_norm_g) X(const float*, w_out) X(const float*, final_g) \
 X(float*, out) X(unsigned*, bar) \
X(bf16_t*, wint) X(bf16_t*, woutt) X(bf16_t*, fnett) X(bf16_t*, H) X(bf16_t*, Z) X(bf16_t*, ZT) X(bf16_t*, YCAT) X(bf16_t*, YA) X(bf16_t*, YAT) X(bf16_t*, CST) X(bf16_t*, WA) X(bf16_t*, HB) X(bf16_t*, HBC) X(bf16_t*, SPm) X(bf16_t*, SPg) X(bf16_t*, QSm) X(bf16_t*, QSg) X(bf16_t*, KSTm) X(bf16_t*, KSTg) X(bf16_t*, VTm) X(bf16_t*, VTg) X(bf16_t*, UCST) \
X(float*, adapart) X(float*, mod) X(float*, ZG) X(float*, X1) X(float*, KT) X(float*, KTC) X(float*, YBT) X(float*, LI) X(float*, BG) X(float*, MG) X(float*, DECm) X(float*, DECg) X(float*, CLm) X(float*, OM) X(float*, OG) X(float*, KSCR) X(float*, KPRE) X(float*, PART)
struct MP {
#define MP_DECL(T, f) T f;
    MP_FIELDS(MP_DECL)
#undef MP_DECL
    int ph_begin, ph_end;
};
__device__ __forceinline__ const void* mp_rfl(const LAS void* const* slot) {
    const unsigned long long v = *(const LAS unsigned long long*)slot;
    const unsigned lo = __builtin_amdgcn_readfirstlane((unsigned)v), hi = __builtin_amdgcn_readfirstlane((unsigned)(v >> 32));
    typedef __attribute__((address_space(1))) const void* gptr_t;
    return (const void*)(gptr_t)(((unsigned long long)hi << 32) | lo);
}
__device__ __forceinline__ MP mp_load(const LAS MP* lp) {
    MP q; asm volatile("" ::: "memory");
#define MP_LD(T, f) q.f = (T)mp_rfl((const LAS void* const*)&lp->f);
    MP_FIELDS(MP_LD)
#undef MP_LD
    q.ph_begin = 0; q.ph_end = 0; return q;
}
constexpr int MEGA_BARW_OFF = 152704;
constexpr int MEGA_PAR_OFF = 152720;
constexpr int MEGA_LDS_BYTES = 153344;

struct WTile { const float* src; bf16_t* dst; int K, srcN, n0, k0; bool map; };
__device__ __forceinline__ void wtile_load(const WTile& w, f32x4 (&v)[8], int tid) {
#pragma unroll
    for (int it = 0; it < 8; ++it) { const int i = it * 512 + tid, kk = i >> 4, n4 = (i & 15) * 4; const int sn = w.map ? win_colmap(w.n0 + n4) : w.n0 + n4;
        v[it] = (f32x4){0.f, 0.f, 0.f, 0.f}; if (sn >= 0) v[it] = *(const f32x4*)(w.src + (size_t)(w.k0 + kk) * w.srcN + sn); }
}
__device__ __forceinline__ void wtile_to_lds(const f32x4 (&v)[8], LAS float* tile, int tid) {
#pragma unroll
    for (int it = 0; it < 8; ++it) { const int i = it * 512 + tid, kk = i >> 4, n4 = (i & 15) * 4;
        tile[kk * 65 + n4] = v[it][0]; tile[kk * 65 + n4 + 1] = v[it][1]; tile[kk * 65 + n4 + 2] = v[it][2]; tile[kk * 65 + n4 + 3] = v[it][3]; }
}
__device__ __forceinline__ void wtile_store(const WTile& w, const LAS float* tile, int tid) {
    const int nl = tid & 15, kl = (tid >> 4) & 3, wv = tid >> 6;
#pragma unroll
    for (int it = 0; it < 4; ++it) { const int bi = it * 8 + wv, nn = (bi & 3) * 16 + nl, k8 = ((bi >> 2) * 4 + kl) * 8;
        u32x4 o; o.x = pack_bf2(tile[k8 * 65 + nn], tile[(k8 + 1) * 65 + nn]); o.y = pack_bf2(tile[(k8 + 2) * 65 + nn], tile[(k8 + 3) * 65 + nn]);
        o.z = pack_bf2(tile[(k8 + 4) * 65 + nn], tile[(k8 + 5) * 65 + nn]); o.w = pack_bf2(tile[(k8 + 6) * 65 + nn], tile[(k8 + 7) * 65 + nn]);
        *(u32x4*)(w.dst + (size_t)(w.n0 + nn) * w.K + w.k0 + k8) = o; }
}
__device__ __forceinline__ void ada_item(int item, const MP& p, LAS float* s) {
    const int tid = lnd(threadIdx.x), cb = item % 6, ks = (item / 6) % ADA_KS, layer = item / (6 * ADA_KS);
    constexpr int KC = D / ADA_KS;
    const int k0 = ks * KC;
    if (tid < 3 * KC) { const int v = tid / KC, kk = tid % KC; const float xv = v < 2 ? p.c[v * D + k0 + kk] : p.c_ctx[k0 + kk]; s[tid] = silu_f(xv); }
    blk_sync();
    const float* w = p.ada_w + (size_t)layer * D * 3 * D + (size_t)k0 * 3 * D + cb * 2048 + tid * 4;
    f32x4 a0 = {0, 0, 0, 0}, a1 = {0, 0, 0, 0}, a2 = {0, 0, 0, 0};
#pragma unroll 8
    for (int kk = 0; kk < KC; ++kk) { const f32x4 wv = *(const f32x4*)(w + (size_t)kk * 3 * D); a0 += s[kk] * wv; a1 += s[KC + kk] * wv; a2 += s[2 * KC + kk] * wv; }
    float* q = p.adapart + ((size_t)(layer * ADA_KS + ks) * 3) * 3 * D + cb * 2048 + tid * 4;
    *(f32x4*)(q) = a0; *(f32x4*)(q + 3 * D) = a1; *(f32x4*)(q + 2 * 3 * D) = a2;
    blk_sync();
}
__device__ __forceinline__ void hid_item(int item, const MP& p, LAS float* sm) {
    const int tid = lnd(threadIdx.x), j = tid & 63, pl = tid >> 6;
    constexpr int PER = (SEQ + CTXL) / 8;
    const int layer = item / PER, rem = item % PER; const bool isctx = rem >= SEQ / 8; const int L = isctx ? CTXL : SEQ; const int pos = (isctx ? rem - SEQ / 8 : rem) * 8 + pl;
    LAS float* feats = sm + pl * 40; LAS float* h1 = sm + 320 + pl * 64;
    const float* w1 = p.hy_f_w1 + layer * 33 * 64; const float* b1 = p.hy_f_b1 + layer * 64; const float* w2 = p.hy_f_w2 + layer * 64 * 64; const float* b2 = p.hy_f_b2 + layer * 64; const float* fr = p.hy_f_freq + layer * 128;
    if (j < 33) {
        if (j == 0) feats[0] = (float)((double)pos / (double)(L - 1));
        else { const int i = (j - 1) & 15; const float band = 1e-4f + (float)i * ((15.0f - 1e-4f) / 15.0f);
            const float rev = (float)pos * band / (float)L;
            feats[j] = j <= 16 ? hw_cos_rev(rev) : -hw_sin_rev(rev); }
    }
    blk_sync();
    float a = b1[j];
    for (int i = 0; i < 33; ++i) a += feats[i] * w1[i * 64 + j];
    h1[j] = sinf(fr[j] * a);
    blk_sync();
    float a2 = b2[j];
    for (int i = 0; i < 64; ++i) a2 += h1[i] * w2[i * 64 + j];
    const float hv = sinf(fr[64 + j] * a2);
    const bf16_t hi = f2bf(hv), lo = f2bf(hv - bf2f(hi));
    bf16_t* row = (isctx ? p.HBC + ((size_t)layer * CTXL + pos) * 256 : p.HB + ((size_t)layer * SEQ + pos) * 256);
    row[j] = hi; row[64 + j] = hi; row[128 + j] = lo; row[192 + j] = 0;
    blk_sync();
}
__device__ __forceinline__ void pro_elem(int idx, const MP& p) {
    if (idx < 2 * 64 * 4096) {
        const int layer = idx / (64 * 4096), rem = idx % (64 * 4096), i = rem / 4096, col = rem % 4096;
        const float wv = p.hy_f_w3[(size_t)layer * 64 * 4096 + rem]; const bf16_t hi = f2bf(wv), lo = f2bf(wv - bf2f(hi));
        bf16_t* row = p.WA + ((size_t)layer * 4096 + col) * 256; row[i] = hi; row[64 + i] = lo; row[128 + i] = hi; row[192 + i] = 0;
    } else { const int e = idx - 2 * 64 * 4096;
        if (e < 512 * 256) { const int m = e >> 8, cc = e & 255, part = m >> 8, cp = m & 255; float s, c; sincospif(2.0f * (float)((cc * cp) & 255) / 256.0f, &s, &c); p.CST[e] = f2bf(part ? s : c); } }
}
constexpr int PRO_ELEMS = 2 * 64 * 4096 + 512 * 256;

__device__ __forceinline__ float half_block_sum(float v, LAS float* red) {
    for (int o = 32; o > 0; o >>= 1) v += __shfl_xor(v, o);
    const int t_ = lnd(threadIdx.x), w = t_ >> 6;
    lds_sync();
    if ((t_ & 63) == 0) red[w] = v;
    lds_sync();
    const int h4 = (w >> 2) * 4;
    return (red[h4] + red[h4 + 1]) + (red[h4 + 2] + red[h4 + 3]);
}
__device__ __forceinline__ f32x4 bf4_to_f32(u32x2 u) { return (f32x4){__uint_as_float(u.x << 16), __uint_as_float(u.x & 0xffff0000u), __uint_as_float(u.y << 16), __uint_as_float(u.y & 0xffff0000u)}; }
__device__ __forceinline__ void norm_phase(int layer, int blk, int G, const MP& p, LAS float* red) {
    const int t_ = lnd(threadIdx.x), tid = t_ & 255, half = t_ >> 8;
    const float* g = p.norm_g + layer * D;
    const bf16_t* P0 = (const bf16_t*)p.X1;
    f32x4 nx[4]; u32x2 np[4];
#pragma unroll
    for (int i = 0; i < 4; ++i) np[i] = (u32x2){0u, 0u};
    const float* gate0c = p.mod + 2 * 3 * D + 2 * D;
#define NORM_LOAD(IT) do { const int r_ = (IT) * 2 + half; \
        if (layer == 1 && r_ >= MLAT) { const size_t rc_ = (size_t)(r_ - MLAT) * D; \
            _Pragma("unroll") for (int i = 0; i < 4; ++i) { const int cc_ = i * 1024 + tid * 4; f32x4 s_ = *(const f32x4*)(p.PART + rc_ + cc_); \
                _Pragma("unroll") for (int ks = 1; ks < 8; ++ks) s_ += *(const f32x4*)(p.PART + (size_t)ks * MCTX * D + rc_ + cc_); \
                nx[i] = *(const f32x4*)(p.ctx + rc_ + cc_) + *(const f32x4*)(gate0c + cc_) * s_; } } \
        else { const float* xr_ = r_ < MLAT ? p.x + (size_t)r_ * D : p.ctx + (size_t)(r_ - MLAT) * D; \
            _Pragma("unroll") for (int i = 0; i < 4; ++i) nx[i] = *(const f32x4*)(xr_ + i * 1024 + tid * 4); \
            if (layer == 1) { _Pragma("unroll") for (int i = 0; i < 4; ++i) np[i] = *(const u32x2*)(P0 + (size_t)r_ * D + i * 1024 + tid * 4); } } } while (0)
    if (blk < MROWS / 2) NORM_LOAD(blk);
    for (int it = blk; it < MROWS / 2; it += G) {
        const int r = it * 2 + half, v = r < MLAT ? r / SEQ : 2;
        const float* shift = p.mod + (size_t)layer * 9 * D + v * 3 * D; const float* scale = shift + D;
        f32x4 xv[4]; float ss = 0.f;
#pragma unroll
        for (int i = 0; i < 4; ++i) { xv[i] = nx[i];
            if (layer == 1 && r < MLAT) xv[i] += *(const f32x4*)(p.mod + v * 3 * D + 2 * D + i * 1024 + tid * 4) * bf4_to_f32(np[i]);
            ss += xv[i][0] * xv[i][0] + xv[i][1] * xv[i][1] + xv[i][2] * xv[i][2] + xv[i][3] * xv[i][3]; }
        if (it + G < MROWS / 2) NORM_LOAD(it + G);
        ss = half_block_sum(ss, red);
        const float rs = rsqrtf(ss * (1.f / D) + EPS);
#pragma unroll
        for (int i = 0; i < 4; ++i) { const int cc = i * 1024 + tid * 4;
            const f32x4 gg = *(const f32x4*)(g + cc), sc = *(const f32x4*)(scale + cc), sh = *(const f32x4*)(shift + cc);
            const f32x4 y = xv[i] * rs * gg * (1.f + sc) + sh;
            u32x2 o; o.x = pack_bf2(y[0], y[1]); o.y = pack_bf2(y[2], y[3]); *(u32x2*)(p.H + (size_t)r * D + cc) = o; }
    }
#undef NORM_LOAD
}
__device__ __forceinline__ void final_phase(int blk, int G, const MP& p, LAS float* red) {
    const int t_ = lnd(threadIdx.x), tid = t_ & 255, half = t_ >> 8;
    const bf16_t* P0 = (const bf16_t*)p.X1; const bf16_t* P1 = P0 + (size_t)MLAT * D;
    f32x4 nx[4]; u32x2 n0[4], n1[4];
#define FIN_LOAD(IT) do { const size_t ro_ = (size_t)((IT) * 2 + half) * D; _Pragma("unroll") for (int i = 0; i < 4; ++i) { const int cc_ = i * 1024 + tid * 4; \
        nx[i] = *(const f32x4*)(p.x + ro_ + cc_); n0[i] = *(const u32x2*)(P0 + ro_ + cc_); n1[i] = *(const u32x2*)(P1 + ro_ + cc_); } } while (0)
    if (blk < MLAT / 2) FIN_LOAD(blk);
    for (int it = blk; it < MLAT / 2; it += G) {
        const int r = it * 2 + half, v = r / SEQ;
        const float* ga0 = p.mod + v * 3 * D + 2 * D; const float* ga1 = p.mod + 9 * D + v * 3 * D + 2 * D;
        f32x4 xv[4]; float ss = 0.f;
#pragma unroll
        for (int i = 0; i < 4; ++i) { const int cc = i * 1024 + tid * 4; xv[i] = nx[i] + *(const f32x4*)(ga0 + cc) * bf4_to_f32(n0[i]) + *(const f32x4*)(ga1 + cc) * bf4_to_f32(n1[i]);
            ss += xv[i][0] * xv[i][0] + xv[i][1] * xv[i][1] + xv[i][2] * xv[i][2] + xv[i][3] * xv[i][3]; }
        if (it + G < MLAT / 2) FIN_LOAD(it + G);
        ss = half_block_sum(ss, red);
        const float rs = rsqrtf(ss * (1.f / D) + EPS);
#pragma unroll
        for (int i = 0; i < 4; ++i) { const int cc = i * 1024 + tid * 4; *(f32x4*)(p.out + (size_t)r * D + cc) = xv[i] * rs * *(const f32x4*)(p.final_g + cc); }
    }
#undef FIN_LOAD
}
__device__ __forceinline__ void combine_phase(int first, int stride, int nitems, int layer, const MP& p) {
    const int t_ = lnd(threadIdx.x), tid = t_ & 255, cc = tid * 4, half = t_ >> 8;
    const f32x4 gn = *(const f32x4*)(p.gla_norm_g + layer * 1024 + cc);
    f32x4 nom0, nom1, nog0, nog1; u32x2 nco, ncg, ndg;
#define CMB_LOAD(IT) do { const size_t r_ = (size_t)(IT) * 2 + half; \
        nom0 = *(const f32x4*)(p.OM + r_ * 1024 + cc); nom1 = *(const f32x4*)(p.OM + ((size_t)MROWS + r_) * 1024 + cc); nog0 = *(const f32x4*)(p.OG + r_ * 1024 + cc); nog1 = *(const f32x4*)(p.OG + ((size_t)MROWS + r_) * 1024 + cc); \
        nco = *(const u32x2*)(p.Z + r_ * NP + ZC_CO + cc); ncg = *(const u32x2*)(p.Z + r_ * NP + ZC_CG + cc); ndg = *(const u32x2*)(p.Z + r_ * NP + ZC_DG + cc); } while (0)
    if (first < nitems) CMB_LOAD(first);
    for (int it = first; it < nitems; it += stride) {
        const size_t r = (size_t)it * 2 + half;
        const f32x4 om = nom0 + nom1, og = nog0 + nog1; const u32x2 co = nco, cg = ncg, dg = ndg;
        if (it + stride < nitems) CMB_LOAD(it + stride);
        float ss = og[0] * og[0] + og[1] * og[1] + og[2] * og[2] + og[3] * og[3];
        for (int o = 32; o > 0; o >>= 1) ss += __shfl_xor(ss, o);
        const float rs = rsqrtf(ss * (1.f / 256.f) + EPS);
        const float cov[4] = {__uint_as_float(co.x << 16), __uint_as_float(co.x & 0xffff0000u), __uint_as_float(co.y << 16), __uint_as_float(co.y & 0xffff0000u)};
        const float cgv[4] = {__uint_as_float(cg.x << 16), __uint_as_float(cg.x & 0xffff0000u), __uint_as_float(cg.y << 16), __uint_as_float(cg.y & 0xffff0000u)};
        const float dgv[4] = {__uint_as_float(dg.x << 16), __uint_as_float(dg.x & 0xffff0000u), __uint_as_float(dg.y << 16), __uint_as_float(dg.y & 0xffff0000u)};
        float yc[4], yd[4];
#pragma unroll
        for (int j = 0; j < 4; ++j) { yc[j] = om[j] * sigmoid_f(cov[j]) * silu_f(cgv[j]); yd[j] = og[j] * rs * gn[j] * silu_f(dgv[j]); }
        u32x2 w; w.x = pack_bf2(yc[0], yc[1]); w.y = pack_bf2(yc[2], yc[3]); *(u32x2*)(p.YCAT + r * D + 2048 + cc) = w;
        w.x = pack_bf2(yd[0], yd[1]); w.y = pack_bf2(yd[2], yd[3]); *(u32x2*)(p.YCAT + r * D + 3072 + cc) = w;
    }
#undef CMB_LOAD
}
template <int MODE> __device__ __forceinline__ void tr_out_phase(int first, int stride, int count, const MP& p, LAS float* tile) {
    const int tid = lnd(threadIdx.x);
    f32x4 nv[2]; u32x4 ngz = {0u, 0u, 0u, 0u};
#define TRO_LOAD(ID) do { const int r0_ = ((ID) >> 4) * 64, c0_ = ((ID) & 15) * 64; \
        _Pragma("unroll") for (int it = 0; it < 2; ++it) { const int i = it * 512 + tid, cc = i >> 4, r4 = (i & 15) * 4; \
            if (MODE) nv[it] = *(const f32x4*)(p.YBT + (size_t)(c0_ + cc) * MLAT + r0_ + r4); \
            else { const u32x2 u = *(const u32x2*)(p.YAT + (size_t)(c0_ + cc) * MLAT + r0_ + r4); nv[it] = (f32x4){__uint_as_float(u.x << 16), __uint_as_float(u.x & 0xffff0000u), __uint_as_float(u.y << 16), __uint_as_float(u.y & 0xffff0000u)}; } } \
        if (MODE) ngz = *(const u32x4*)(p.Z + (size_t)(r0_ + (tid >> 3)) * NP + ZC_BG + c0_ + (tid & 7) * 8); } while (0)
    if (first < count) TRO_LOAD(first);
    for (int id = first; id < count; id += stride) {
        const int r0 = (id >> 4) * 64, c0 = (id & 15) * 64;
#pragma unroll
        for (int it = 0; it < 2; ++it) { const int i = it * 512 + tid, cc = i >> 4, r4 = (i & 15) * 4;
            tile[cc * 65 + r4] = nv[it][0]; tile[cc * 65 + r4 + 1] = nv[it][1]; tile[cc * 65 + r4 + 2] = nv[it][2]; tile[cc * 65 + r4 + 3] = nv[it][3]; }
        const u32x4 gz = ngz;
        lds_sync();
        if (id + stride < count) TRO_LOAD(id + stride);
        { const int rr = tid >> 3, c8 = (tid & 7) * 8; const size_t r = r0 + rr; float v[8];
#pragma unroll
          for (int j = 0; j < 8; ++j) v[j] = tile[(c8 + j) * 65 + rr];
          if (MODE) {
              const float gv[8] = {__uint_as_float(gz.x << 16), __uint_as_float(gz.x & 0xffff0000u), __uint_as_float(gz.y << 16), __uint_as_float(gz.y & 0xffff0000u), __uint_as_float(gz.z << 16), __uint_as_float(gz.z & 0xffff0000u), __uint_as_float(gz.w << 16), __uint_as_float(gz.w & 0xffff0000u)};
#pragma unroll
              for (int j = 0; j < 8; ++j) v[j] *= silu_f(gv[j]); }
          u32x4 o; o.x = pack_bf2(v[0], v[1]); o.y = pack_bf2(v[2], v[3]); o.z = pack_bf2(v[4], v[5]); o.w = pack_bf2(v[6], v[7]);
          if (MODE) *(u32x4*)(p.YCAT + r * D + 1024 + c0 + c8) = o; else *(u32x4*)(p.YA + r * 1024 + c0 + c8) = o; }
        lds_sync();
    }
#undef TRO_LOAD
    __syncthreads();
}
__device__ __forceinline__ void hyena_ctx_item(int c, int layer, const MP& p, LAS float* sm) {
    const int tid = lnd(threadIdx.x), b = tid >> 8, t = tid & 255;
    LAS float* kb = sm; LAS float* vb = sm + 512; LAS float* red = sm + 1024;
    const float* cw = p.hy_conv_w + (size_t)layer * 3 * 3072; const float* cb = p.hy_conv_b + layer * 3072; const float* hbias = p.hy_bias + layer * 2048;
    const float* KTC = p.KTC + (size_t)layer * 4096 * CTXL;
    float xc[3];
#pragma unroll
    for (int i = 0; i < 3; ++i) { const int ch = i * 1024 + c; const bf16_t* row = p.ZT + (size_t)ch * MROWS + MLAT + b * CTXL;
        const float um = t > 0 ? bf2f(row[t - 1]) : 0.f, u0 = bf2f(row[t]), up = t < CTXL - 1 ? bf2f(row[t + 1]) : 0.f;
        xc[i] = cw[ch] * um + cw[3072 + ch] * u0 + cw[2 * 3072 + ch] * up + cb[ch]; }
    float xin = xc[0];
    float kvo[2];
#pragma unroll
    for (int o = 0; o < 2; ++o) { kvo[o] = 0.f; if (tid < CTXL) kvo[o] = KTC[(size_t)((o * 2) * 1024 + c) * CTXL + tid]; else if (tid > CTXL) kvo[o] = KTC[(size_t)((o * 2 + 1) * 1024 + c) * CTXL + (2 * CTXL - tid)]; }
    const size_t r = MLAT + b * CTXL + t;
    const bf16_t gate = p.Z[r * NP + ZC_BG + c];
#pragma unroll
    for (int o = 0; o < 2; ++o) {
        const float kv = kvo[o];
        float l1 = fabsf(kv);
        for (int oo = 32; oo > 0; oo >>= 1) l1 += __shfl_xor(l1, oo);
        blk_sync();
        if ((tid & 63) == 0) red[tid >> 6] = l1;
        kb[(tid + CTXL) & (2 * CTXL - 1)] = kv; vb[tid] = xin;
        blk_sync();
        const float nrm = ((red[0] + red[1]) + (red[2] + red[3])) + ((red[4] + red[5]) + (red[6] + red[7])) + EPS;
        float y = 0.f;
#pragma unroll 16
        for (int s = 0; s < CTXL; ++s) y += vb[b * CTXL + s] * kb[CTXL + t - s];
        xin = xc[o + 1] * (y * frcp(nrm) + hbias[o * 1024 + c] * xin);
    }
    p.YCAT[r * D + 1024 + c] = f2bf(xin * silu_f(bf2f(gate)));
    blk_sync();
}
__device__ __forceinline__ void fourier_ctx_item(int cp, const MP& p, LAS float* sm) {
    const int tid = lnd(threadIdx.x), b = tid >> 8, lp = tid & 255;
    LAS float* uc = sm; LAS float* us = sm + 512; LAS float* cs = sm + 1024; LAS float* sn = sm + 1280;
    uc[tid] = bf2f(p.UCST[(size_t)cp * MROWS + MLAT + tid]); us[tid] = bf2f(p.UCST[(size_t)(1024 + cp) * MROWS + MLAT + tid]);
    if (tid < 256) { const float rv = (float)tid * (1.0f / 256.0f); cs[tid] = hw_cos_rev(rv); sn[tid] = hw_sin_rev(rv); }
    blk_sync();
    float y = 0.f; const float cw = cs[lp], sw = sn[lp];
    const LAS float* ucb = uc + b * CTXL; const LAS float* usb = us + b * CTXL;
#pragma unroll 1
    for (int l0 = 0; l0 < CTXL; l0 += 32) { const int idx = (l0 * lp) & 255; float c = cs[idx], s = sn[idx];
#pragma unroll
        for (int j = 0; j < 32; ++j) { y += c * ucb[l0 + j] - s * usb[l0 + j]; const float cn = c * cw - s * sw; s = c * sw + s * cw; c = cn; } }
    p.YA[(size_t)(MLAT + b * CTXL + lp) * 1024 + cp] = f2bf(y * (1.0f / 256.0f));
    blk_sync();
}

struct InProjSched : pg8::StaticOrder {
    __device__ bool next(int i, pg8::Unit& u) const { if (!pg8::StaticOrder::next(i, u)) return false;
        if (u.pn >= ZC_BU / 256 && u.pn < ZC_BG / 256) { u.aux = 1; const char* t = u.a; u.a = u.b; u.b = t; } else u.aux = (u.pn == NTN_IN - 1) ? 2 : 0; return true; }
};
#ifndef CTXU
#define CTXU 15
#endif
struct InProjSchedLast : InProjSched {
    static constexpr int NLAT = (MLAT / 256) * NTN_IN, NCTX = (MCTX / 256) * CTXU;
    __device__ bool next(int i, pg8::Unit& u) const { const long L = (long)i * G + c; if (L >= NLAT + NCTX) return false;
        const int w = (int)L;
        if (w < NLAT) { u.pn = w % NTN_IN; u.pm = w / NTN_IN; }
        else { const int jj = w - NLAT, j = jj % CTXU; u.pm = MLAT / 256 + jj / CTXU;
            u.pn = CTXU == 57 ? j : (j < 4 ? ZC_CK / 256 + j : j < 8 ? ZC_CV / 256 + (j - 4) : j < 10 ? ZC_DK / 256 + (j - 8) : j < 14 ? ZC_DV / 256 + (j - 10) : NTN_IN - 1); }
        u.a = A + (size_t)u.pm * tsA; u.b = B + (size_t)u.pn * tsB;
        if (u.pn >= ZC_BU / 256 && u.pn < ZC_BG / 256) { u.aux = 1; const char* t = u.a; u.a = u.b; u.b = t; } else u.aux = (u.pn == NTN_IN - 1) ? 2 : 0; return true; }
};
#ifdef PROBE_L2GEMM
struct ProbeSched : pg8::StaticOrder {
    __device__ bool next(int i, pg8::Unit& u) const { if (!pg8::StaticOrder::next(i, u)) return false; u.a = A; u.b = B; u.aux = 0; return true; }
};
struct EpiProbe {
    static constexpr bool PERM = true, AFTER_DRAIN = false;
    float* sink;
    __device__ __forceinline__ void operator()(const f32x4 (&acc)[2][2][4][2], const pg8::Unit& u, int wr, int wc, int fr, int fq) const {
        float s = 0.f;
#pragma unroll
        for (int ai = 0; ai < 2; ++ai)
#pragma unroll
            for (int bj = 0; bj < 2; ++bj)
#pragma unroll
                for (int m = 0; m < 4; ++m)
#pragma unroll
                    for (int n = 0; n < 2; ++n) s += acc[ai][bj][m][n][0] + acc[ai][bj][m][n][1] + acc[ai][bj][m][n][2] + acc[ai][bj][m][n][3];
        if (s == 1.2345678e33f) sink[0] = s;
    }
};
#endif
struct EpiInProj2 {
    static constexpr bool PERM = true, AFTER_DRAIN = false;
    bf16_t* Z; bf16_t* ZT; float* ZG;
    __device__ __forceinline__ void operator()(const f32x4 (&acc)[2][2][4][2], const pg8::Unit& u, int wr, int wc, int fr, int fq) const {
        if (u.aux == 2) { const int row0 = u.pm * 256 + wr * 64 + fr, col0 = wc * 32 + 8 * fq;
#pragma unroll
            for (int ai = 0; ai < 2; ++ai)
#pragma unroll
                for (int m = 0; m < 4; ++m) { float* rowp = ZG + (size_t)(row0 + ai * 128 + m * 16) * 256 + col0;
#pragma unroll
                    for (int bj = 0; bj < 2; ++bj) { *(f32x4*)(rowp + bj * 128) = acc[ai][bj][m][0]; *(f32x4*)(rowp + bj * 128 + 4) = acc[ai][bj][m][1]; } }
            return; }
        const int rt = u.aux ? u.pn : u.pm, ct = u.aux ? u.pm : u.pn;
        bf16_t* base = u.aux ? ZT - (size_t)ZC_BU * MROWS : Z; const size_t ld = u.aux ? MROWS : NP;
        const int row0 = rt * 256 + wr * 64 + fr, col0 = ct * 256 + wc * 32 + 8 * fq;
#pragma unroll
        for (int ai = 0; ai < 2; ++ai)
#pragma unroll
            for (int m = 0; m < 4; ++m) { bf16_t* rowp = base + (size_t)(row0 + ai * 128 + m * 16) * ld + col0;
#pragma unroll
                for (int bj = 0; bj < 2; ++bj) { const f32x4 v0 = acc[ai][bj][m][0], v1 = acc[ai][bj][m][1];
                    u32x4 w; w.x = pg8::cvt_pk_bf16(v0[0], v0[1]); w.y = pg8::cvt_pk_bf16(v0[2], v0[3]); w.z = pg8::cvt_pk_bf16(v1[0], v1[1]); w.w = pg8::cvt_pk_bf16(v1[2], v1[3]);
                    *(u32x4*)(rowp + bj * 128) = w; } }
    }
};
struct EpiOut2 {
    static constexpr bool PERM = true, AFTER_DRAIN = false;
    bf16_t* P;
    __device__ __forceinline__ void operator()(const f32x4 (&acc)[2][2][4][2], const pg8::Unit& u, int wr, int wc, int fr, int fq) const {
        const int row0 = u.pm * 256 + wr * 64 + fr, col0 = u.pn * 256 + wc * 32 + 8 * fq;
#pragma unroll
        for (int ai = 0; ai < 2; ++ai)
#pragma unroll
            for (int m = 0; m < 4; ++m) { bf16_t* rowp = P + (size_t)(row0 + ai * 128 + m * 16) * D + col0;
#pragma unroll
                for (int bj = 0; bj < 2; ++bj) { const f32x4 v0 = acc[ai][bj][m][0], v1 = acc[ai][bj][m][1];
                    u32x4 w; w.x = pg8::cvt_pk_bf16(v0[0], v0[1]); w.y = pg8::cvt_pk_bf16(v0[2], v0[3]); w.z = pg8::cvt_pk_bf16(v1[0], v1[1]); w.w = pg8::cvt_pk_bf16(v1[2], v1[3]);
                    *(u32x4*)(rowp + bj * 128) = w; } }
    }
};
struct EpiFnet2 {
    static constexpr bool PERM = true, AFTER_DRAIN = false;
    const bf16_t* Z; bf16_t* ycat;
    __device__ __forceinline__ void operator()(const f32x4 (&acc)[2][2][4][2], const pg8::Unit& u, int wr, int wc, int fr, int fq) const {
        const int row0 = u.pm * 256 + wr * 64 + fr, col0 = u.pn * 256 + wc * 32 + 8 * fq;
#pragma unroll
        for (int ai = 0; ai < 2; ++ai)
#pragma unroll
            for (int m = 0; m < 4; ++m) { const int r = row0 + ai * 128 + m * 16;
#pragma unroll
                for (int bj = 0; bj < 2; ++bj) { const int cc = col0 + bj * 128;
                    const u32x4 gz = *(const u32x4*)(Z + (size_t)r * NP + ZC_AG + cc);
                    const float gv[8] = {__uint_as_float(gz.x << 16), __uint_as_float(gz.x & 0xffff0000u), __uint_as_float(gz.y << 16), __uint_as_float(gz.y & 0xffff0000u), __uint_as_float(gz.z << 16), __uint_as_float(gz.z & 0xffff0000u), __uint_as_float(gz.w << 16), __uint_as_float(gz.w & 0xffff0000u)};
                    const f32x4 v0 = acc[ai][bj][m][0], v1 = acc[ai][bj][m][1];
                    u32x4 w; w.x = pg8::cvt_pk_bf16(v0[0] * silu_f(gv[0]), v0[1] * silu_f(gv[1])); w.y = pg8::cvt_pk_bf16(v0[2] * silu_f(gv[2]), v0[3] * silu_f(gv[3]));
                    w.z = pg8::cvt_pk_bf16(v1[0] * silu_f(gv[4]), v1[1] * silu_f(gv[5])); w.w = pg8::cvt_pk_bf16(v1[2] * silu_f(gv[6]), v1[3] * silu_f(gv[7]));
                    *(u32x4*)(ycat + (size_t)r * D + cc) = w; } }
    }
};
struct CtxSplitSched {
    int G, c; const char* A; const char* B;
    __device__ bool next(int i, pg8::Unit& u) const { const long Lx = (long)i * G + c; if (Lx >= 256) return false;
        const int pn = (int)Lx & 15, pm2 = ((int)Lx >> 4) & 1, ks = (int)Lx >> 5; u.pm = pm2; u.pn = pn; u.aux = ks;
        u.a = A + ((size_t)(MLAT / 256 + pm2) * 256 * D + ks * 512) * 2; u.b = B + ((size_t)pn * 256 * D + ks * 512) * 2; return true; }
    __device__ __forceinline__ void a_ready(const pg8::Unit&) const {}
    __device__ __forceinline__ void done(const pg8::Unit&) const {}
};
struct EpiCtxPart {
    static constexpr bool PERM = true, AFTER_DRAIN = false;
    float* PART;
    __device__ __forceinline__ void operator()(const f32x4 (&acc)[2][2][4][2], const pg8::Unit& u, int wr, int wc, int fr, int fq) const {
        const int row0 = u.pm * 256 + wr * 64 + fr, col0 = u.pn * 256 + wc * 32 + 8 * fq;
        float* base = PART + (size_t)u.aux * MCTX * D;
#pragma unroll
        for (int ai = 0; ai < 2; ++ai)
#pragma unroll
            for (int m = 0; m < 4; ++m) { float* rowp = base + (size_t)(row0 + ai * 128 + m * 16) * D + col0;
#pragma unroll
                for (int bj = 0; bj < 2; ++bj) { *(f32x4*)(rowp + bj * 128) = acc[ai][bj][m][0]; *(f32x4*)(rowp + bj * 128 + 4) = acc[ai][bj][m][1]; } }
    }
};
struct EpiFilt {
    static constexpr bool PERM = true, AFTER_DRAIN = false;
    float* KT; int L;
    __device__ __forceinline__ void operator()(const f32x4 (&acc)[2][2][4][2], const pg8::Unit& u, int wr, int wc, int fr, int fq) const {
        const int row0 = u.pm * 256 + wr * 64 + fr, col0 = u.pn * 256 + wc * 32 + 8 * fq;
        const float inv = 1.0f / (float)(L - 1);
#pragma unroll
        for (int ai = 0; ai < 2; ++ai)
#pragma unroll
            for (int m = 0; m < 4; ++m) { const int col = row0 + ai * 128 + m * 16; const float delta = fabsf(HY_SLOW + (HY_FAST - HY_SLOW) * ((float)(col & 1023) / 1023.0f));
#pragma unroll
                for (int bj = 0; bj < 2; ++bj)
#pragma unroll
                    for (int n = 0; n < 2; ++n) { const int pos = col0 + bj * 128 + 4 * n; f32x4 o;
#pragma unroll
                        for (int j = 0; j < 4; ++j) o[j] = acc[ai][bj][m][n][j] * fexp(-(float)(pos + j) * inv * delta);
                        *(f32x4*)(KT + (size_t)col * L + pos) = o; } }
    }
};
struct ChDftSched {
    int G, c; const char* A; const char* Zb; int nt;
    __device__ bool next(int i, pg8::Unit& u) const { const long Lx = (long)i * G + c; if (Lx >= 4 * 2 * nt) return false;
        const int g = (int)(Lx / (2 * nt)), rem = (int)(Lx % (2 * nt)); u.pm = rem & 1; u.pn = rem >> 1; u.aux = g;
        u.a = A + (size_t)u.pm * 256 * 256 * 2; u.b = Zb + ((size_t)u.pn * 256 * NP + ZC_AU + g * 256) * 2; return true; }
    __device__ __forceinline__ void a_ready(const pg8::Unit&) const {}
    __device__ __forceinline__ void done(const pg8::Unit&) const {}
};
struct EpiChDft {
    static constexpr bool PERM = true, AFTER_DRAIN = false;
    bf16_t* UCST;
    __device__ __forceinline__ void operator()(const f32x4 (&acc)[2][2][4][2], const pg8::Unit& u, int wr, int wc, int fr, int fq) const {
        const int cp0 = wr * 64 + fr, col0 = u.pn * 256 + wc * 32 + 8 * fq;
#pragma unroll
        for (int ai = 0; ai < 2; ++ai)
#pragma unroll
            for (int m = 0; m < 4; ++m) { const int orow = u.pm * 1024 + u.aux * 256 + cp0 + ai * 128 + m * 16;
#pragma unroll
                for (int bj = 0; bj < 2; ++bj) { const f32x4 v0 = acc[ai][bj][m][0], v1 = acc[ai][bj][m][1];
                    u32x4 w; w.x = pg8::cvt_pk_bf16(v0[0], v0[1]); w.y = pg8::cvt_pk_bf16(v0[2], v0[3]); w.z = pg8::cvt_pk_bf16(v1[0], v1[1]); w.w = pg8::cvt_pk_bf16(v1[2], v1[3]);
                    *(u32x4*)(UCST + (size_t)orow * MROWS + col0 + bj * 128) = w; } }
    }
};
constexpr int NPHASE = 17;
constexpr int NPRE = 0;
#ifndef STAGGER
#define STAGGER 7
#endif
#ifndef FILT_IN_TAIL
#define FILT_IN_TAIL 1
#endif
#ifndef CTX_RM
#define CTX_RM 1
#endif
#ifndef PH_MASK
#define PH_MASK 0x1FFFF
#endif
#ifndef MIX1_MASK
#define MIX1_MASK 31
#endif
#define M1_EN(x) (((MIX1_MASK) >> (x)) & 1)
#ifndef M1REP_MASK
#define M1REP_MASK 0
#endif
#define M1_REPS(x) ((((M1REP_MASK) >> (x)) & 1) ? (REP_N) : 1)
#ifndef REP_MASK
#define REP_MASK 0
#endif
#ifndef REP_N
#define REP_N 1
#endif
#define PH_REPS(x) ((((REP_MASK) >> (x)) & 1) ? (REP_N) : 1)
#define PH_EN(x) (((PH_MASK) >> (x)) & 1)
template <class Epi, class Sched> __device__ __forceinline__ void run_gemm(LAS unsigned char* lds, const pg8::Gemm& g, const Sched& S, const Epi& E) {
    pg8::gemm_phase<Epi, Sched, false>((PG8_LAS unsigned char*)lds, g, S, E, nullptr);
    __syncthreads();
}
constexpr int T_IN = (NP / 64) * (D / 256), T_OUT = (D / 64) * (D / 256), T_FN = (GW / 64) * (GW / 256), T_L = T_IN + T_OUT + T_FN;
__device__ __forceinline__ WTile pro_wtile_desc(int r, int l, const MP& p) {
    WTile w;
    if (r < T_IN) { w.src = p.w_in + (size_t)l * D * PROJ_W; w.dst = p.wint + (size_t)l * NP * D; w.K = D; w.srcN = PROJ_W; w.n0 = (r % (NP / 64)) * 64; w.k0 = (r / (NP / 64)) * 256; w.map = true; }
    else if ((r -= T_IN) < T_OUT) { w.src = p.w_out + (size_t)l * D * D; w.dst = p.woutt + (size_t)l * D * D; w.K = D; w.srcN = D; w.n0 = (r % (D / 64)) * 64; w.k0 = (r / (D / 64)) * 256; w.map = false; }
    else { r -= T_OUT; w.src = p.fnet_w + (size_t)l * GW * GW; w.dst = p.fnett + (size_t)l * GW * GW; w.K = GW; w.srcN = GW; w.n0 = (r % (GW / 64)) * 64; w.k0 = (r / (GW / 64)) * 256; w.map = false; }
    return w;
}
__device__ __forceinline__ void pro_wtiles(int base, int first, int stride, int count, int l, const MP& p, LAS float* ldsf) {
    const int tid = lnd(threadIdx.x);
    f32x4 va[8], vb[8];
    if (first < count) { const WTile w0 = pro_wtile_desc(base + first, l, p); wtile_load(w0, va, tid); }
    if (first + stride < count) { const WTile w1 = pro_wtile_desc(base + first + stride, l, p); wtile_load(w1, vb, tid); }
    for (int it = first; it < count; it += 2 * stride) {
        {
            const WTile w = pro_wtile_desc(base + it, l, p);
            wtile_to_lds(va, ldsf, tid);
            lds_sync();
            if (it + 2 * stride < count) { const WTile wn = pro_wtile_desc(base + it + 2 * stride, l, p); wtile_load(wn, va, tid); }
            wtile_store(w, ldsf, tid);
            lds_sync();
        }
        if (it + stride < count) {
            const WTile w = pro_wtile_desc(base + it + stride, l, p);
            wtile_to_lds(vb, ldsf, tid);
            lds_sync();
            if (it + 3 * stride < count) { const WTile wn = pro_wtile_desc(base + it + 3 * stride, l, p); wtile_load(wn, vb, tid); }
            wtile_store(w, ldsf, tid);
            lds_sync();
        }
    }
    __syncthreads();
}
__device__ __forceinline__ void tail_share(int nwg, int G, int blk, int& first, int& stride) {
    const int rem = nwg % G;
    if (rem == 0) { first = blk; stride = G; } else if (blk >= rem) { first = blk - rem; stride = G - rem; } else { first = 0x3fffffff; stride = 1; }
}
__device__ __forceinline__ void mod_final(int layer, int blk, int G, int tid, const MP& p) {
    for (int j = blk * 512 + lnd(tid); j < 9 * D; j += G * 512) { const int i = layer * 9 * D + j, n = j % (3 * D), v = j / (3 * D);
        float a = p.ada_b[layer * 3 * D + n];
        for (int ks = 0; ks < ADA_KS; ++ks) a += p.adapart[((size_t)(layer * ADA_KS + ks) * 3 + v) * 3 * D + n];
        p.mod[i] = a; }
}
__device__ __forceinline__ void filter_gemm(int l, bool with_ctx, LAS unsigned char* lds, int blk, int G, const MP& p) {
    { pg8::Gemm g{p.WA + (size_t)l * 4096 * 256, p.HB + (size_t)l * SEQ * 256, 4096, SEQ, 256, 256, 256, 0}; pg8::StaticOrder S; S.init(g, G, blk); EpiFilt E{p.KT + (size_t)l * 4096 * SEQ, SEQ}; run_gemm(lds, g, S, E); }
    if (with_ctx) { pg8::Gemm g{p.WA + (size_t)l * 4096 * 256, p.HBC + (size_t)l * CTXL * 256, 4096, CTXL, 256, 256, 256, 0}; pg8::StaticOrder S; S.init(g, G, blk); EpiFilt E{p.KTC + (size_t)l * 4096 * CTXL, CTXL}; run_gemm(lds, g, S, E); }
}
template <int l> __device__ __forceinline__ void layer_phases(const LAS MP* lp, LAS unsigned char* lds, LAS float* ldsf, const XcdBarrier& bar, int pb, int pe, int tid, int blk, int G) {
    constexpr int ph0 = 2 + 7 * l; constexpr bool last = (l == 1);
#define PHASE_ON(ph) (PH_EN(ph) && (ph) >= pb && (ph) < pe)
#define PHASE_SYNC(ph) do { if ((ph) >= pb && (ph) + 1 < pe) xcd_barrier(bar); } while (0)

        if (PHASE_ON(ph0)) for (int rep_ = 0; rep_ < PH_REPS(ph0); ++rep_) { const MP p = mp_load(lp); norm_phase(l, blk, G, p, ldsf); }
        PHASE_SYNC(ph0);
#ifdef PROBE_L2GEMM
        if (PHASE_ON(ph0 + 1)) { const MP p = mp_load(lp); pg8::Gemm g{p.H, p.wint + (size_t)l * NP * D, MROWS, NP, D, D, D, 0};
#if PROBE_L2GEMM == 1
            ProbeSched S;
#else
            InProjSched S;
#endif
            S.init(g, G, blk); EpiProbe E{p.KSCR}; run_gemm(lds, g, S, E); }
#endif
        if (PHASE_ON(ph0 + 1)) for (int rep_ = 0; rep_ < PH_REPS(ph0 + 1); ++rep_) { const MP p = mp_load(lp); pg8::Gemm g{p.H, p.wint + (size_t)l * NP * D, MROWS, NP, D, D, D, 0}; InProjSched S; S.init(g, G, blk); EpiInProj2 E{p.Z, p.ZT, p.ZG};
            if (l == 1 && CTX_RM) { InProjSchedLast S3; S3.init(g, G, blk); run_gemm(lds, g, S3, E); } else
            run_gemm(lds, g, S, E);
            if (l == 0) { int f0, st; tail_share((MROWS / 256) * NTN_IN, G, blk, f0, st);
                pro_wtiles(T_IN + T_OUT, f0, st, T_FN, 1, p, ldsf);
                for (int it = f0; it < ADA_KS * 6; it += st) ada_item(ADA_KS * 6 + it, p, ldsf);
                for (int it = f0; it < (SEQ + CTXL) / 8; it += st) hid_item((SEQ + CTXL) / 8 + it, p, ldsf); }
            if (l == 1 && FILT_IN_TAIL) { int f0, st; tail_share(CTX_RM ? InProjSchedLast::NLAT + InProjSchedLast::NCTX : (MROWS / 256) * NTN_IN, G, blk, f0, st);
                if (f0 < st) filter_gemm(1, false, lds, f0, st, p); }
            if (l == 1) { int f0, st; tail_share((MROWS / 256) * NTN_IN, G, blk, f0, st);
                for (int c = f0; c < NPRE; c += st) { const int t_ = lnd(tid); const FftTw w = fft_make_tw(t_ & 255);
                    for (int o = 0; o < 2; ++o) { cf Kr[16]; float fr[16]; hyena_taps(c, o, p.KT + (size_t)l * 4096 * SEQ, fr, t_); hyena_kspec(fr, Kr, lds, w, t_); cf* dst = (cf*)p.KPRE + ((size_t)c * 2 + o) * 16 * 512;
#pragma unroll
                        for (int pp = 0; pp < 16; ++pp) dst[pp * 512 + t_] = Kr[pp]; __syncthreads(); } } } }
        PHASE_SYNC(ph0 + 1);
        if (PHASE_ON(ph0 + 2)) for (int rep_ = 0; rep_ < PH_REPS(ph0 + 2); ++rep_) { const MP p = mp_load(lp);
            for (int r1_ = 0; r1_ < M1_REPS(0); ++r1_) if (M1_EN(0)) { pg8::Gemm g{p.CST, p.Z, 512, MROWS, 256, 256, NP, 0}; ChDftSched S; S.G = G; S.c = blk; S.nt = last ? MLAT / 256 : MROWS / 256; S.A = (const char*)p.CST; S.Zb = (const char*)p.Z; EpiChDft E{p.UCST}; run_gemm(lds, g, S, E); }
            for (int r1_ = 0; r1_ < M1_REPS(1); ++r1_) if (M1_EN(1)) { u32x4 rr[6]; if (blk < 1024) hyena_rows(blk, p.ZT, rr, lnd(tid));
                for (int c = blk; c < 1024; c += G) hyena_item(c, p.ZT, p.KT + (size_t)l * 4096 * SEQ, p.hy_conv_w + (size_t)l * 3 * 3072, p.hy_conv_b + l * 3072, p.hy_bias + l * 2048, p.YBT, (cf*)p.KSCR + (size_t)blk * 16 * 512,
                                                               (l == 1 && c < NPRE) ? (const cf*)p.KPRE + (size_t)c * 2 * 16 * 512 : nullptr, c + G < 1024 ? c + G : -1, rr, lds); }
            for (int r1_ = 0; r1_ < M1_REPS(2); ++r1_) if (M1_EN(2) && !last) { for (int c = blk; c < 1024; c += G) hyena_ctx_item(c, l, p, ldsf); }
            for (int r1_ = 0; r1_ < M1_REPS(3); ++r1_) if (M1_EN(3)) for (int s = G - 1 - blk; s >= 0 && s < 16; s += G) gate_scan_item(s, p.ZG, p.ml_gate_b + l * 16, p.LI, p.BG, p.MG, lds);
            for (int r1_ = 0; r1_ < M1_REPS(4); ++r1_) if (M1_EN(4)) for (int it = (blk + G / 2) % G; it < 16 * NCHUNK; it += G) gla_s1_item(it / NCHUNK, it % NCHUNK, p.Z, p.ZG, p.gla_w2 + (size_t)l * 2 * 16 * 512, p.gla_b2 + l * 1024, p.SPg, p.QSg, p.KSTg, p.DECg, p.VTg, lds);
        }
        PHASE_SYNC(ph0 + 2);
        if (PHASE_ON(ph0 + 3)) for (int rep_ = 0; rep_ < PH_REPS(ph0 + 3); ++rep_) { const MP p = mp_load(lp);
            const bool tr_first = (STAGGER & 2) && (((blk >> 3) & 1) != 0);
            constexpr int NTR = (MLAT / 64) * 16, NX5 = 16 * NCHUNK - 4 * 256; const bool trb = (G == 256);
            const int trf = !trb ? blk : blk < NX5 ? blk : 2 * NX5 + (blk - NX5), trs = !trb ? G : blk < NX5 ? NX5 : G - NX5, trc = !trb ? NTR : blk < NX5 ? 2 * NX5 : NTR;
            if (tr_first) tr_out_phase<1>(trf, trs, trc, p, ldsf);
            { const FftTw w = fft_make_tw(lnd(tid) & 255); u32x4 rr[4]; if (blk < 1024) fourier_rows(blk, p.UCST, rr, lnd(tid));
              for (int c = blk; c < 1024; c += G) fourier_item(c, p.UCST, p.YAT, c + G < 1024 ? c + G : -1, rr, lds, w); }
            if (!last) { for (int c = blk; c < 1024; c += G) fourier_ctx_item(c, p, ldsf); }
            for (int it = blk; it < 16 * NCHUNK; it += G) { u32x2 rq[10], rk[10]; ml_s1_rows(it / NCHUNK, it % NCHUNK, p.Z, rq, rk, lnd(tid));
                ml_s1_item(it / NCHUNK, it % NCHUNK, p.ml_conv_w + (size_t)l * 6 * 1024, p.ml_conv_b + l * 2048, p.Z, p.LI, p.BG, p.MG, p.SPm, p.QSm, p.KSTm, p.DECm, p.CLm, p.VTm, -1, rq, rk, lds); }
            if (!tr_first) tr_out_phase<1>(trf, trs, trc, p, ldsf);
        }
        PHASE_SYNC(ph0 + 3);
        if (PHASE_ON(ph0 + 4)) for (int rep_ = 0; rep_ < PH_REPS(ph0 + 4); ++rep_) { const MP p = mp_load(lp);
            const bool tr_first = (STAGGER & 4) && (((blk >> 3) & 1) != 0);
            if (tr_first) tr_out_phase<0>(blk, G, (MLAT / 64) * 16, p, ldsf);
            for (int it = blk; it < 256; it += G) {
                const int grp = (it & 7) * 4 + ((it >> 3) & 3), slice = it >> 5;
                if (grp < 16) scan_item<0>(grp, slice, p.SPm, p.QSm, p.KSTm, p.VTm, p.DECm, p.CLm, p.OM, lds);
                else scan_item<1>(grp - 16, slice, p.SPg, p.QSg, p.KSTg, p.VTg, p.DECg, nullptr, p.OG, lds);
            }
            if (!tr_first) tr_out_phase<0>(blk, G, (MLAT / 64) * 16, p, ldsf);
        }
        PHASE_SYNC(ph0 + 4);
        if (PHASE_ON(ph0 + 5)) for (int rep_ = 0; rep_ < PH_REPS(ph0 + 5); ++rep_) { const MP p = mp_load(lp);
            const int mrows = last ? MLAT : MROWS;
            { pg8::Gemm g{p.YA, p.fnett + (size_t)l * GW * GW, mrows, GW, GW, GW, GW, 0}; pg8::StaticOrder S; S.init(g, G, blk); EpiFnet2 E{p.Z, p.YCAT}; run_gemm(lds, g, S, E); }
            { const int nun = (mrows / 256) * (GW / 256); const int nfree = G - nun;
              constexpr int CMB_G = 7; const int nit = mrows / 2, ng = nfree > 0 ? nit - CMB_G * nun : 0;
              if (nfree > 0) { if (blk >= nun) combine_phase(blk - nun, nfree, ng, l, p); else combine_phase(ng + blk, nun, nit, l, p); }
              else combine_phase(blk, G, nit, l, p); }
            if (l == 0) { mod_final(1, blk, G, tid, p);
                if (!FILT_IN_TAIL) filter_gemm(1, false, lds, blk, G, p); }
        }
        PHASE_SYNC(ph0 + 5);
        if (PHASE_ON(ph0 + 6)) for (int rep_ = 0; rep_ < PH_REPS(ph0 + 6); ++rep_) { const MP p = mp_load(lp);
            const bool copy_first = (l == 0) && (STAGGER & 1) && (((blk >> 3) & 1) != 0);
            if (copy_first) pro_wtiles(0, blk, G, T_IN + T_OUT, 1, p, ldsf);
            pg8::Gemm g{p.YCAT, p.woutt + (size_t)l * D * D, MLAT, D, D, D, D, 0}; pg8::StaticOrder S; S.init(g, G, blk); EpiOut2 E{(bf16_t*)p.X1 + (size_t)l * MLAT * D};
            run_gemm(lds, g, S, E);
            if (l == 0) {
                { pg8::Gemm g2{p.YCAT, p.woutt + (size_t)l * D * D, MCTX, D, 512, D, D, 0}; CtxSplitSched S2; S2.G = G; S2.c = blk; S2.A = (const char*)p.YCAT; S2.B = (const char*)(p.woutt + (size_t)l * D * D); EpiCtxPart E2{p.PART}; run_gemm(lds, g2, S2, E2); }
                if (!copy_first) pro_wtiles(0, blk, G, T_IN + T_OUT, 1, p, ldsf); }
        }
        PHASE_SYNC(ph0 + 6);
    #undef PHASE_ON
#undef PHASE_SYNC
}
__global__ __launch_bounds__(512, 2) void mega(MP kp) {
    extern __shared__ __attribute__((aligned(16))) unsigned char shm[];
    LAS unsigned char* lds = (LAS unsigned char*)shm;
    LAS float* ldsf = (LAS float*)shm;
    const int tid = threadIdx.x, blk = blockIdx.x, G = gridDim.x;
    static_assert(sizeof(MP) == 552 && MEGA_PAR_OFF + sizeof(MP) <= MEGA_LDS_BYTES && FFT_LDS_BYTES <= MEGA_BARW_OFF && S1_LDS_BYTES <= MEGA_BARW_OFF && MEGA_LDS_BYTES <= 163840, "LDS map");
    const LAS MP* lp = (const LAS MP*)(lds + MEGA_PAR_OFF);
    if (tid < 4) ((LAS unsigned*)(lds + MEGA_BARW_OFF))[tid] = 0u;
    if (tid == 0) { LAS MP* wp = (LAS MP*)(lds + MEGA_PAR_OFF);
#define MP_ST(T, f) wp->f = kp.f;
        MP_FIELDS(MP_ST)
#undef MP_ST
    }
    __syncthreads();
    XcdBarrier bar = xcd_barrier_post(kp.bar, (volatile LAS unsigned*)(lds + MEGA_BARW_OFF));
    const int pb = kp.ph_begin, pe = kp.ph_end;
#define PHASE_ON(ph) (PH_EN(ph) && (ph) >= pb && (ph) < pe)
#define PHASE_SYNC(ph) do { if ((ph) >= pb && (ph) + 1 < pe) xcd_barrier(bar); } while (0)

    if (PHASE_ON(0)) for (int rep_ = 0; rep_ < PH_REPS(0); ++rep_) { const MP p = mp_load(lp);
        pro_wtiles(0, blk, G, T_L, 0, p, ldsf);
        for (int it = blk; it < ADA_KS * 6; it += G) ada_item(it, p, ldsf);
        for (int it = blk; it < (SEQ + CTXL) / 8; it += G) hid_item(it, p, ldsf);
        for (int i = blk * 512 + lnd(tid); i < PRO_ELEMS; i += G * 512) pro_elem(i, p);
    }
    PHASE_SYNC(0);
    if (PHASE_ON(1)) for (int rep_ = 0; rep_ < PH_REPS(1); ++rep_) { const MP p = mp_load(lp);
        mod_final(0, blk, G, tid, p);
        filter_gemm(0, true, lds, blk, G, p);
    }
    PHASE_SYNC(1);
    layer_phases<0>(lp, lds, ldsf, bar, pb, pe, tid, blk, G);
    layer_phases<1>(lp, lds, ldsf, bar, pb, pe, tid, blk, G);
    if (PHASE_ON(16)) for (int rep_ = 0; rep_ < PH_REPS(16); ++rep_) { const MP p = mp_load(lp); final_phase(blk, G, p, ldsf); }
#undef PHASE_ON
#undef PHASE_SYNC
}

struct WsMap2 { size_t off[64]; size_t end; };
extern "C" void kernel_launch(void* const* d_in, const int* in_sizes, int n_in, void* d_out, int out_size, void* d_ws, size_t ws_size, hipStream_t stream) {
    static int grid = 0; static size_t need = 0; static MP base;
    char* ws = (char*)d_ws;
    if (!grid) {
        int dev = 0, cus = 0, per_cu = 0;
        (void)hipGetDevice(&dev); (void)hipDeviceGetAttribute(&cus, hipDeviceAttributeMultiprocessorCount, dev); if (cus <= 0) cus = 256;
        if (hipFuncSetAttribute((const void*)mega, hipFuncAttributeMaxDynamicSharedMemorySize, MEGA_LDS_BYTES) != hipSuccess) fprintf(stderr, "kernel_launch: hipFuncSetAttribute failed\n");
        if (hipOccupancyMaxActiveBlocksPerMultiprocessor(&per_cu, (const void*)mega, 512, MEGA_LDS_BYTES) != hipSuccess || per_cu < 1) fprintf(stderr, "kernel_launch: occupancy query says %d blocks per CU\n", per_cu);
        grid = cus;
        memset(&base, 0, sizeof(base));
        size_t o = 1u << 20;
        auto take = [&](size_t bytes) { size_t r = o; o += (bytes + 255) & ~(size_t)255; return r; };
#define TAKE(field, type, bytes) base.field = (type*)(size_t)take(bytes)
        TAKE(wint, bf16_t, (size_t)2 * NP * D * 2); TAKE(woutt, bf16_t, (size_t)2 * D * D * 2); TAKE(fnett, bf16_t, (size_t)2 * GW * GW * 2);
        TAKE(H, bf16_t, (size_t)MROWS * D * 2); TAKE(Z, bf16_t, (size_t)MROWS * NP * 2); TAKE(ZT, bf16_t, (size_t)3072 * MROWS * 2); TAKE(YCAT, bf16_t, (size_t)MROWS * D * 2);
        TAKE(YA, bf16_t, (size_t)MROWS * 1024 * 2); TAKE(YAT, bf16_t, (size_t)1024 * MLAT * 2); TAKE(CST, bf16_t, (size_t)512 * 256 * 2); TAKE(WA, bf16_t, (size_t)2 * 4096 * 256 * 2);
        TAKE(HB, bf16_t, (size_t)2 * SEQ * 256 * 2); TAKE(UCST, bf16_t, (size_t)2048 * MROWS * 2); TAKE(HBC, bf16_t, (size_t)2 * CTXL * 256 * 2);
        { const size_t NI = (size_t)16 * NCHUNK; TAKE(SPm, bf16_t, NI * 4096 * 2); TAKE(SPg, bf16_t, NI * 4096 * 2); TAKE(QSm, bf16_t, NI * 64 * 256 * 2); TAKE(QSg, bf16_t, NI * 64 * 128 * 2);
          TAKE(KSTm, bf16_t, NI * 256 * 64 * 2); TAKE(KSTg, bf16_t, NI * 128 * 64 * 2); TAKE(VTm, bf16_t, (size_t)8 * NCHUNK * 256 * 64 * 2); TAKE(VTg, bf16_t, (size_t)8 * NCHUNK * 256 * 64 * 2);
          TAKE(DECm, float, NI * 256 * 4); TAKE(DECg, float, NI * 128 * 4); TAKE(CLm, float, NI * 64 * 4); }
        TAKE(adapart, float, (size_t)2 * ADA_KS * 3 * 3 * D * 4); TAKE(mod, float, (size_t)2 * 9 * D * 4); TAKE(ZG, float, (size_t)MROWS * 256 * 4); TAKE(X1, float, (size_t)MROWS * D * 4);
        TAKE(KT, float, (size_t)2 * 4096 * SEQ * 4); TAKE(KTC, float, (size_t)2 * 4096 * CTXL * 4); TAKE(YBT, float, (size_t)1024 * MLAT * 4);
        TAKE(LI, float, (size_t)16 * SEQP * 4); TAKE(BG, float, (size_t)16 * SEQP * 4); TAKE(MG, float, (size_t)16 * SEQP * 4); TAKE(OM, float, (size_t)2 * MROWS * 1024 * 4); TAKE(OG, float, (size_t)2 * MROWS * 1024 * 4); TAKE(KSCR, float, (size_t)1024 * 16 * 512 * 8); TAKE(KPRE, float, (size_t)NPRE * 2 * 16 * 512 * 8); TAKE(PART, float, (size_t)8 * MCTX * D * 4);
#undef TAKE
        need = o;
    }
    if (ws_size < need || n_in != 26) { fprintf(stderr, "kernel_launch: need %zu bytes of workspace (have %zu), 26 inputs (have %d)\n", need, ws_size, n_in); return; }
    MP p = base;
    {
        bf16_t** bp[] = {&p.wint, &p.woutt, &p.fnett, &p.H, &p.Z, &p.ZT, &p.YCAT, &p.YA, &p.YAT, &p.CST, &p.WA, &p.HB, &p.HBC, &p.SPm, &p.SPg, &p.QSm, &p.QSg, &p.KSTm, &p.KSTg, &p.VTm, &p.VTg, &p.UCST};
        for (auto q : bp) *q = (bf16_t*)(ws + (size_t)*q);
        float** fp[] = {&p.adapart, &p.mod, &p.ZG, &p.X1, &p.KT, &p.KTC, &p.YBT, &p.LI, &p.BG, &p.MG, &p.DECm, &p.DECg, &p.CLm, &p.OM, &p.OG, &p.KSCR, &p.KPRE, &p.PART};
        for (auto q : fp) *q = (float*)(ws + (size_t)*q);
    }
    const float** ins[] = {&p.x, &p.c, &p.ctx, &p.c_ctx, &p.ada_w, &p.ada_b, &p.norm_g, &p.w_in, &p.fnet_w, &p.hy_conv_w, &p.hy_conv_b, &p.hy_f_w1, &p.hy_f_b1, &p.hy_f_w2, &p.hy_f_b2, &p.hy_f_w3, &p.hy_f_freq, &p.hy_bias,
                           &p.ml_conv_w, &p.ml_conv_b, &p.ml_gate_b, &p.gla_w2, &p.gla_b2, &p.gla_norm_g, &p.w_out, &p.final_g};
    for (int i = 0; i < 26; ++i) *ins[i] = (const float*)d_in[i];
    p.out = (float*)d_out; p.bar = (unsigned*)ws;
    (void)hipMemsetAsync(ws, 0, 65536, stream);
#ifndef MEGA_SPLIT
    p.ph_begin = 0; p.ph_end = NPHASE;
    hipLaunchKernelGGL(mega, dim3(grid), dim3(512), MEGA_LDS_BYTES, stream, p);
#else
    for (int ph = 0; ph < NPHASE; ++ph) { p.ph_begin = ph; p.ph_end = ph + 1; hipLaunchKernelGGL(mega, dim3(grid), dim3(512), MEGA_LDS_BYTES, stream, p); }
#endif
}
```

```cpp
#include <hip/hip_runtime.h>
#include <stdio.h>
#include <stdint.h>
#include <math.h>

#include <string.h>
namespace pg8 {
#define PG8_LAS __attribute__((address_space(3)))
typedef unsigned short bf16_t;
typedef short bf16x8 __attribute__((ext_vector_type(8)));
typedef float f32x4 __attribute__((ext_vector_type(4)));
typedef unsigned u32x4 __attribute__((ext_vector_type(4)));
constexpr int BM = 256, BK = 64, HALF = 128, HTB = HALF * BK * 2  , STAGE_BYTES = 8 * HTB, NXCD = 8, WGM = 8;

__host__ __device__ __forceinline__ int lds_byte(int r, int c) { const int st = (r >> 4) * 2 + (c >> 5), rr = r & 15, cc = c & 31, ob = rr * 64 + cc * 2; return st * 1024 + (ob ^ (((ob >> 9) & 1) << 5)); }
__host__ __device__ __forceinline__ void stage_rc(int b, int& R, int& C) { const int st = b / 1024, sb = b % 1024, swz = sb ^ (((sb >> 9) & 1) << 5); R = (st >> 1) * 16 + swz / 64; C = (st & 1) * 32 + (swz % 64) / 2; }
__host__ __device__ __forceinline__ int perm32(int rho) { const int n = rho >> 4, i = rho & 15; return 8 * (i >> 2) + 4 * n + (i & 3); }

struct Unit { const char* a; const char* b; int pm, pn, aux; };
struct Gemm { const bf16_t* A; const bf16_t* Bt; int M, N, K, lda, ldb, pad; };

struct StaticOrder {
    int nM, nN, nwg, G, c; const char* A; const char* B; size_t tsA, tsB;
    __host__ __device__ void init(const Gemm& g, int G_, int c_) { nM = g.M / BM; nN = g.N / BM; nwg = nM * nN; G = G_; c = c_; A = (const char*)g.A; B = (const char*)g.Bt; tsA = (size_t)BM * g.lda * 2; tsB = (size_t)BM * g.ldb * 2; }
    __host__ __device__ bool next(int i, Unit& u) const {
        const long L = (long)i * G + c; if (L >= nwg) return false;
        int wgid = (int)L; { const int q = nwg / NXCD, r = nwg % NXCD, xcd = wgid % NXCD, off = wgid / NXCD; wgid = (xcd < r ? xcd * (q + 1) : r * (q + 1) + (xcd - r) * q) + off; }
        const int nig = WGM * nN, gid = wgid / nig, fm = gid * WGM, gsz = (nM - fm) < WGM ? (nM - fm) : WGM;
        u.pm = fm + ((wgid % nig) % gsz); u.pn = (wgid % nig) / gsz; u.aux = 0; u.a = A + (size_t)u.pm * tsA; u.b = B + (size_t)u.pn * tsB; return true;
    }
    __device__ __forceinline__ void a_ready(const Unit&) const {}
    __device__ __forceinline__ void done(const Unit&) const {}
};

__device__ __forceinline__ unsigned cvt_pk_bf16(float lo, float hi) { unsigned r; asm volatile("v_cvt_pk_bf16_f32 %0, %1, %2" : "=v"(r) : "v"(lo), "v"(hi)); return r; }

template <class Epi, class Sched, bool STAMP = false>
__device__ __forceinline__ void gemm_phase(PG8_LAS unsigned char* lds, const Gemm g, const Sched& S, const Epi& E, unsigned long long* stamps) {
    int tid_l = threadIdx.x; asm volatile("" : "+v"(tid_l));
    const int tid = tid_l, wid = __builtin_amdgcn_readfirstlane(tid >> 6), lane = tid & 63, wr = wid >> 2, wc = wid & 3, fr = lane & 15, fq = lane >> 4;
    const int K = g.K, nt = K / BK;
    int ts_lo = 0, ts_hi = 0, nts = 0; const unsigned long long rt_entry = STAMP ? (unsigned long long)wall_clock64() : 0ull;
#define PG8_STAMP() do { if (STAMP && wid == 0 && nts < 64) { const unsigned long long _c = (unsigned long long)clock64(); \
        ts_lo = (lane == nts) ? (int)(unsigned)_c : ts_lo; ts_hi = (lane == nts) ? (int)(unsigned)(_c >> 32) : ts_hi; ++nts; } } while (0)
    PG8_STAMP();
    unsigned voffA[2], voffB[2];
#pragma unroll
    for (int i = 0; i < 2; ++i) { int R, C; stage_rc(tid * 16 + i * 8192, R, C); const int Rb = Epi::PERM ? ((R & ~31) + perm32(R & 31)) : R;
        voffA[i] = (unsigned)(R * g.lda + C) * 2u; voffB[i] = (unsigned)(Rb * g.ldb + C) * 2u; }
    const size_t kstep = (size_t)(BK * 2);
    const size_t hstepA = (size_t)HALF * g.lda * 2, hstepB = (size_t)HALF * g.ldb * 2;
    const unsigned ldsw = (unsigned)wid * 1024u;
    const int aoff = lds_byte(wr * 64 + fr, fq * 8), boff = lds_byte(wc * 32 + fr, fq * 8);
#define PG8_SA(b, h) (((b) * 2 + (h)) * HTB)
#define PG8_SB(b, h) ((4 + (b) * 2 + (h)) * HTB)
#define PG8_STAGE(bufoff, gbase, voff) do { _Pragma("unroll") for (int _i = 0; _i < 2; ++_i) \
        __builtin_amdgcn_global_load_lds((const unsigned*)((const char*)(gbase) + (voff)[_i]), (PG8_LAS unsigned*)(lds + (bufoff) + ldsw + _i * 8192), 16, 0, 0); } while (0)
#define PG8_LDA(dst, b, h) do { _Pragma("unroll") for (int m = 0; m < 4; ++m) _Pragma("unroll") for (int k = 0; k < 2; ++k) dst[m][k] = *(const PG8_LAS bf16x8*)(lds + PG8_SA(b, h) + aoff + m * 2048 + k * 1024); } while (0)
#define PG8_LDB(dst, b, h) do { _Pragma("unroll") for (int n = 0; n < 2; ++n) _Pragma("unroll") for (int k = 0; k < 2; ++k) dst[n][k] = *(const PG8_LAS bf16x8*)(lds + PG8_SB(b, h) + boff + n * 2048 + k * 1024); } while (0)
#define PG8_MMA(ai, bj, At, Bt) do { __builtin_amdgcn_s_setprio(1); _Pragma("unroll") for (int m = 0; m < 4; ++m) _Pragma("unroll") for (int n = 0; n < 2; ++n) _Pragma("unroll") for (int k = 0; k < 2; ++k) \
        acc[ai][bj][m][n] = __builtin_amdgcn_mfma_f32_16x16x32_bf16(Bt[n][k], At[m][k], acc[ai][bj][m][n], 0, 0, 0); __builtin_amdgcn_s_setprio(0); } while (0)
#define PG8_WAIT_V(n) asm volatile("s_waitcnt vmcnt(" #n ")" ::: "memory")
#define PG8_WAIT_L(n) asm volatile("s_waitcnt lgkmcnt(" #n ")" ::: "memory")
#define PG8_BAR __builtin_amdgcn_s_barrier()
#define PG8_SCHED __builtin_amdgcn_sched_barrier(0)
    Unit cur, nxt; int ui = 0;
    if (!S.next(0, cur)) return;
    f32x4 acc[2][2][4][2];
#pragma unroll
    for (int a = 0; a < 2; ++a)
#pragma unroll
        for (int b = 0; b < 2; ++b)
#pragma unroll
            for (int m = 0; m < 4; ++m)
#pragma unroll
                for (int n = 0; n < 2; ++n) acc[a][b][m][n] = (f32x4){0.f, 0.f, 0.f, 0.f};
    bf16x8 At[4][2], B0[2][2], B1[2][2];
    const char* cA = cur.a; const char* cB = cur.b;
    S.a_ready(cur);
    PG8_STAGE(PG8_SB(0, 0), cB, voffB); PG8_STAGE(PG8_SA(0, 0), cA, voffA); PG8_STAGE(PG8_SB(0, 1), cB + hstepB, voffB); PG8_STAGE(PG8_SA(0, 1), cA + hstepA, voffA);
    if (wr == 1) PG8_BAR;
    PG8_WAIT_V(4); PG8_BAR;
    PG8_STAGE(PG8_SB(1, 0), cB + kstep, voffB); PG8_STAGE(PG8_SA(1, 0), cA + kstep, voffA); PG8_STAGE(PG8_SB(1, 1), cB + hstepB + kstep, voffB);
    PG8_WAIT_V(6); PG8_BAR;
    PG8_STAMP();
    for (;;) {
        const bool has_next = S.next(ui + 1, nxt);
        const char* nA = has_next ? nxt.a : cA; const char* nB = has_next ? nxt.b : cB;
        for (int t = 0; t < nt; t += 2) {
            const bool last = (t == nt - 2);
            const char* a1 = cA + (size_t)(t + 1) * kstep;
            const char* a2 = last ? nA : cA + (size_t)(t + 2) * kstep; const char* b2 = last ? nB : cB + (size_t)(t + 2) * kstep;
            const char* a3 = a2 + kstep; const char* b3 = b2 + kstep;
            if (last && has_next) S.a_ready(nxt);
            PG8_LDB(B0, 0, 0); PG8_SCHED; PG8_LDA(At, 0, 0); PG8_STAGE(PG8_SA(1, 1), a1 + hstepA, voffA);
            PG8_WAIT_L(8); PG8_BAR; PG8_WAIT_L(0); PG8_MMA(0, 0, At, B0); PG8_BAR; PG8_SCHED;
            PG8_LDB(B1, 0, 1); PG8_STAGE(PG8_SB(0, 0), b2, voffB);
            PG8_BAR; PG8_WAIT_L(0); PG8_MMA(0, 1, At, B1); PG8_BAR;
            PG8_LDA(At, 0, 1); PG8_STAGE(PG8_SA(0, 0), a2, voffA);
            PG8_BAR; PG8_WAIT_L(0); PG8_MMA(1, 0, At, B0); PG8_BAR; PG8_SCHED;
            PG8_STAGE(PG8_SB(0, 1), b2 + hstepB, voffB);
            PG8_WAIT_V(6); PG8_BAR; PG8_MMA(1, 1, At, B1); PG8_BAR;
            PG8_LDB(B0, 1, 0); PG8_SCHED; PG8_LDA(At, 1, 0); PG8_STAGE(PG8_SA(0, 1), a2 + hstepA, voffA);
            PG8_WAIT_L(8); PG8_BAR; PG8_WAIT_L(0); PG8_MMA(0, 0, At, B0); PG8_BAR; PG8_SCHED;
            PG8_LDB(B1, 1, 1); PG8_STAGE(PG8_SB(1, 0), b3, voffB);
            PG8_BAR; PG8_WAIT_L(0); PG8_MMA(0, 1, At, B1); PG8_BAR;
            PG8_LDA(At, 1, 1); PG8_STAGE(PG8_SA(1, 0), a3, voffA);
            PG8_BAR; PG8_WAIT_L(0); PG8_MMA(1, 0, At, B0); PG8_BAR; PG8_SCHED;
            PG8_STAGE(PG8_SB(1, 1), b3 + hstepB, voffB);
            PG8_WAIT_V(6); PG8_BAR; PG8_MMA(1, 1, At, B1); PG8_BAR;
        }
        PG8_STAMP();
        if constexpr (!Epi::AFTER_DRAIN) { E(acc, cur, wr, wc, fr, fq); S.done(cur); }
        PG8_STAMP();
        if (!has_next) break;
#pragma unroll
        for (int a = 0; a < 2; ++a)
#pragma unroll
            for (int b = 0; b < 2; ++b)
#pragma unroll
                for (int m = 0; m < 4; ++m)
#pragma unroll
                    for (int n = 0; n < 2; ++n) acc[a][b][m][n] = (f32x4){0.f, 0.f, 0.f, 0.f};
        cur = nxt; cA = nA; cB = nB; ++ui;
    }
    PG8_WAIT_V(0);
    if (wr == 0) PG8_BAR;
    PG8_BAR;
    if constexpr (Epi::AFTER_DRAIN) { E.fused(acc, cur, wr, wc, fr, fq, lds, wid, lane); S.done(cur); }
    PG8_STAMP();
    if (STAMP && wid == 0) { stamps[lane] = lane < nts ? (((unsigned long long)(unsigned)ts_hi << 32) | (unsigned)ts_lo) : 0ull;
        if (lane == 62) stamps[62] = rt_entry; if (lane == 63) stamps[63] = (unsigned long long)wall_clock64(); }
#undef PG8_STAMP
#undef PG8_SA
#undef PG8_SB
#undef PG8_STAGE
#undef PG8_LDA
#undef PG8_LDB
#undef PG8_MMA
#undef PG8_WAIT_V
#undef PG8_WAIT_L
#undef PG8_BAR
#undef PG8_SCHED
}
}

typedef unsigned short bf16_t;
typedef float f32x4 __attribute__((ext_vector_type(4)));
typedef unsigned u32x4 __attribute__((ext_vector_type(4)));
typedef unsigned u32x2 __attribute__((ext_vector_type(2)));
#define LAS __attribute__((address_space(3)))

constexpr int D = 4096, NB = 2, SEQ = 4096, CTXL = 256, GW = 1024;
constexpr int MLAT = NB * SEQ, MCTX = NB * CTXL, MROWS = MLAT + MCTX;
constexpr int PROJ_W = 14384, NP = 14592;
constexpr int ZC_AU = 0, ZC_AG = 1024, ZC_BU = 2048, ZC_BG = 5120, ZC_CQ = 6144, ZC_CK = 7168, ZC_CV = 8192, ZC_CO = 9216, ZC_CG = 10240,
              ZC_DQ = 11264, ZC_DK = 11776, ZC_DV = 12288, ZC_DG = 13312, ZC_GATE = 14336;
constexpr int NTN_IN = NP / 256;
constexpr float EPS = 1e-6f;
constexpr int ADA_KS = 32;
constexpr int SEQP = CTXL + SEQ;

__device__ __forceinline__ int lnd(int v) {
#ifndef EMU
    asm volatile("" : "+v"(v));
#endif
    return v;
}
__device__ __forceinline__ void blk_sync() {
    __syncthreads();
}
__device__ __forceinline__ void lds_sync() {
#ifndef EMU
    asm volatile("s_waitcnt lgkmcnt(0)\n\ts_barrier" ::: "memory");
#else
    __syncthreads();
#endif
}
__device__ __forceinline__ float bf2f(bf16_t b) { return __uint_as_float(((unsigned)b) << 16); }
__device__ __forceinline__ bf16_t f2bf(float f) { unsigned u = __float_as_uint(f); u += 0x7FFFu + ((u >> 16) & 1u); return (bf16_t)(u >> 16); }
__device__ __forceinline__ float fexp(float x) { return __expf(x); }
__device__ __forceinline__ float frcp(float x) { return __builtin_amdgcn_rcpf(x); }
__device__ __forceinline__ float silu_f(float x) { return x * frcp(1.f + fexp(-x)); }
__device__ __forceinline__ float sigmoid_f(float x) { return frcp(1.f + fexp(-x)); }
__device__ __forceinline__ float logsigmoid_f(float x) { return fminf(x, 0.f) - log1pf(expf(-fabsf(x))); }
__device__ __forceinline__ float logsigmoid_fast(float x) { return fminf(x, 0.f) - __logf(1.f + fexp(-fabsf(x))); }

__device__ __forceinline__ int win_colmap(int n) {
    if (n < 11264) return n;
    if (n < 14336) return n + 16;
    if (n < 14352) return n - 14336 + 11264;
    if (n < 14384) return n;
    return -1;
}
constexpr float HY_FAST = -15.350567286626973f, HY_SLOW = -3.0701134573253946f;
#define HD __host__ __device__ __forceinline__
typedef float cf __attribute__((ext_vector_type(2)));
#if defined(__HIP_DEVICE_COMPILE__) && !defined(EMU)
#define CF_ASM 1
#endif
HD inline cf cmul(cf a, cf b) {
#ifdef CF_ASM
    cf t, r;
    asm("v_pk_mul_f32 %0, %1, %2 op_sel:[0,0] op_sel_hi:[0,1]" : "=v"(t) : "v"(a), "v"(b));
    asm("v_pk_fma_f32 %0, %1, %2, %3 op_sel:[1,1,0] op_sel_hi:[1,0,1] neg_lo:[0,1,0]" : "=v"(r) : "v"(a), "v"(b), "v"(t));
    return r;
#else
    return cf{a.x * b.x - a.y * b.y, a.x * b.y + a.y * b.x};
#endif
}
HD inline cf cmulc(cf a, cf b) {
#ifdef CF_ASM
    cf t, r;
    asm("v_pk_mul_f32 %0, %1, %2 op_sel:[0,0] op_sel_hi:[0,1] neg_hi:[0,1]" : "=v"(t) : "v"(a), "v"(b));
    asm("v_pk_fma_f32 %0, %1, %2, %3 op_sel:[1,1,0] op_sel_hi:[1,0,1]" : "=v"(r) : "v"(a), "v"(b), "v"(t));
    return r;
#else
    return cf{a.x * b.x + a.y * b.y, a.y * b.x - a.x * b.y};
#endif
}
HD inline cf cadd_mi(cf a, cf b) {
#ifdef CF_ASM
    cf r; asm("v_pk_add_f32 %0, %1, %2 op_sel:[0,1] op_sel_hi:[1,0] neg_hi:[0,1]" : "=v"(r) : "v"(a), "v"(b)); return r;
#else
    return cf{a.x + b.y, a.y - b.x};
#endif
}
HD inline cf cadd_pi(cf a, cf b) {
#ifdef CF_ASM
    cf r; asm("v_pk_add_f32 %0, %1, %2 op_sel:[0,1] op_sel_hi:[1,0] neg_lo:[0,1]" : "=v"(r) : "v"(a), "v"(b)); return r;
#else
    return cf{a.x - b.y, a.y + b.x};
#endif
}
template <int SIGN> HD inline void dft4(cf& a, cf& b, cf& c, cf& d) {
    const cf s0 = a + c, d0 = a - c, s1 = b + d, d1 = b - d;
    a = s0 + s1; c = s0 - s1;
    if (SIGN < 0) { b = cadd_mi(d0, d1); d = cadd_pi(d0, d1); }
    else          { b = cadd_pi(d0, d1); d = cadd_mi(d0, d1); }
}
#define DFT16_T(k) ((((k) & 3) << 2) | ((k) >> 2))
template <int SIGN, bool TIN = false> HD inline void dft16(cf (&x)[16]) {
    const float C1 = 0.92387953251128674f, S1 = 0.38268343236508977f, R2 = 0.70710678118654752f;
    const float sg = SIGN < 0 ? -1.f : 1.f;
    const cf w1{C1, sg * S1}, w2{R2, sg * R2}, w3{S1, sg * C1}, w4{0.f, sg}, w6{-R2, sg * R2}, w9{-C1, -sg * S1};
    if (!TIN) {
#pragma unroll
        for (int n2 = 0; n2 < 4; ++n2) dft4<SIGN>(x[n2], x[4 + n2], x[8 + n2], x[12 + n2]);
        x[4 * 1 + 1] = cmul(x[4 * 1 + 1], w1); x[4 * 1 + 2] = cmul(x[4 * 1 + 2], w2); x[4 * 1 + 3] = cmul(x[4 * 1 + 3], w3);
        x[4 * 2 + 1] = cmul(x[4 * 2 + 1], w2); x[4 * 2 + 2] = cmul(x[4 * 2 + 2], w4); x[4 * 2 + 3] = cmul(x[4 * 2 + 3], w6);
        x[4 * 3 + 1] = cmul(x[4 * 3 + 1], w3); x[4 * 3 + 2] = cmul(x[4 * 3 + 2], w6); x[4 * 3 + 3] = cmul(x[4 * 3 + 3], w9);
#pragma unroll
        for (int k1 = 0; k1 < 4; ++k1) dft4<SIGN>(x[4 * k1], x[4 * k1 + 1], x[4 * k1 + 2], x[4 * k1 + 3]);
    } else {
#pragma unroll
        for (int n2 = 0; n2 < 4; ++n2) dft4<SIGN>(x[4 * n2], x[4 * n2 + 1], x[4 * n2 + 2], x[4 * n2 + 3]);
        x[4 * 1 + 1] = cmul(x[4 * 1 + 1], w1); x[4 * 2 + 1] = cmul(x[4 * 2 + 1], w2); x[4 * 3 + 1] = cmul(x[4 * 3 + 1], w3);
        x[4 * 1 + 2] = cmul(x[4 * 1 + 2], w2); x[4 * 2 + 2] = cmul(x[4 * 2 + 2], w4); x[4 * 3 + 2] = cmul(x[4 * 3 + 2], w6);
        x[4 * 1 + 3] = cmul(x[4 * 1 + 3], w3); x[4 * 2 + 3] = cmul(x[4 * 2 + 3], w6); x[4 * 3 + 3] = cmul(x[4 * 3 + 3], w9);
#pragma unroll
        for (int k1 = 0; k1 < 4; ++k1) dft4<SIGN>(x[k1], x[4 + k1], x[8 + k1], x[12 + k1]);
    }
}
constexpr int FFT_BUF_OFF = 0, FFT_BUF_BYTES = 34816, FFT_RED_OFF = FFT_BUF_OFF + 2 * FFT_BUF_BYTES, FFT_UROW_OFF = FFT_RED_OFF + 1024, FFT_Z1_OFF = FFT_UROW_OFF + 3 * 2 * SEQ * 2 + 64, FFT_LDS_BYTES = FFT_Z1_OFF + SEQ * 8;
struct FftTw { cf wa, wb, w8; };
#ifndef EMU
__device__ __forceinline__ float hw_sin_rev(float r) { return __builtin_amdgcn_sinf(r); }
__device__ __forceinline__ float hw_cos_rev(float r) { return __builtin_amdgcn_cosf(r); }
#else
inline float hw_sin_rev(float r) { return (float)sin(2.0 * M_PI * (double)r); }
inline float hw_cos_rev(float r) { return (float)cos(2.0 * M_PI * (double)r); }
#endif
#ifndef EMU
#define FFT_SCHED_FENCE(q) do { if (((q) & 3) == 3) __builtin_amdgcn_sched_barrier(0); } while (0)
#else
#define FFT_SCHED_FENCE(q) do { } while (0)
#endif
__device__ __forceinline__ int fft_launder(int v) {
#ifndef EMU
    asm volatile("" : "+v"(v));
#endif
    return v;
}
__device__ __forceinline__ cf fft_opaque(cf v) {
#ifndef EMU
    float a = v.x, b = v.y; asm volatile("" : "+v"(a), "+v"(b)); return cf{a, b};
#else
    return v;
#endif
}
__device__ __forceinline__ FftTw fft_make_tw(int t) {
    FftTw w;
    const float ra = (float)t * (1.0f / 4096.0f), rb = (float)(t & 15) * (1.0f / 256.0f), r8 = (float)t * (1.0f / 8192.0f);
    w.wa = cf{hw_cos_rev(ra), -hw_sin_rev(ra)}; w.wb = cf{hw_cos_rev(rb), -hw_sin_rev(rb)}; w.w8 = cf{hw_cos_rev(r8), -hw_sin_rev(r8)};
    return w;
}
__device__ __forceinline__ void fft4096_fwd(cf (&x)[16], int t, LAS cf* buf, const FftTw& w) {
    const int s1 = t + (t >> 4), s2 = 272 * (t >> 4) + (t & 15), s3 = 17 * t;
    dft16<-1>(x);
    { const cf w1 = fft_opaque(w.wa); cf wp = w1; buf[s1] = x[0];
#pragma unroll
      for (int p = 1; p < 16; ++p) { buf[s1 + 272 * p] = cmul(x[DFT16_T(p)], wp); wp = cmul(wp, w1); } }
    blk_sync();
#pragma unroll
    for (int q = 0; q < 16; ++q) x[q] = buf[s2 + 17 * q];
    dft16<-1>(x);
    { const cf w1 = fft_opaque(w.wb); cf wp = w1; buf[s2] = x[0];
#pragma unroll
      for (int p = 1; p < 16; ++p) { buf[s2 + 17 * p] = cmul(x[DFT16_T(p)], wp); wp = cmul(wp, w1); } }
    blk_sync();
#pragma unroll
    for (int q = 0; q < 16; ++q) x[q] = buf[s3 + q];
    dft16<-1>(x);
}
__device__ __forceinline__ void fft4096_inv(cf (&x)[16], int t, LAS cf* buf, const FftTw& w) {
    const int s1 = t + (t >> 4), s2 = 272 * (t >> 4) + (t & 15), s3 = 17 * t;
    dft16<1, true>(x);
#pragma unroll
    for (int q = 0; q < 16; ++q) buf[s3 + q] = x[q];
    blk_sync();
    { const cf w1 = fft_opaque(w.wb); cf wp = w1; x[0] = buf[s2];
#pragma unroll
      for (int p = 1; p < 16; ++p) { x[p] = cmulc(buf[s2 + 17 * p], wp); wp = cmul(wp, w1); } }
    dft16<1>(x);
#pragma unroll
    for (int q = 0; q < 16; ++q) buf[s2 + 17 * q] = x[DFT16_T(q)];
    blk_sync();
    { const cf w1 = fft_opaque(w.wa); cf wp = w1; x[0] = buf[s1];
#pragma unroll
      for (int p = 1; p < 16; ++p) { x[p] = cmulc(buf[s1 + 272 * p], wp); wp = cmul(wp, w1); } }
    dft16<1>(x);
}
__device__ __forceinline__ float block_sum_512(float v, LAS float* red) {
    for (int o = 32; o > 0; o >>= 1) v += __shfl_xor(v, o);
    blk_sync();
    { const int t_ = lnd(threadIdx.x); if ((t_ & 63) == 0) red[t_ >> 6] = v; }
    blk_sync();
    return ((red[0] + red[1]) + (red[2] + red[3])) + ((red[4] + red[5]) + (red[6] + red[7]));
}
__device__ __forceinline__ cf w32_pow(int q) {
    const float C[16] = {1.0f, 0.98078528040323043f, 0.92387953251128674f, 0.83146961230254524f, 0.70710678118654752f, 0.55557023301960218f, 0.38268343236508977f, 0.19509032201612825f,
                         0.0f, -0.19509032201612825f, -0.38268343236508977f, -0.55557023301960218f, -0.70710678118654752f, -0.83146961230254524f, -0.92387953251128674f, -0.98078528040323043f};
    const float S[16] = {0.0f, 0.19509032201612825f, 0.38268343236508977f, 0.55557023301960218f, 0.70710678118654752f, 0.83146961230254524f, 0.92387953251128674f, 0.98078528040323043f,
                         1.0f, 0.98078528040323043f, 0.92387953251128674f, 0.83146961230254524f, 0.70710678118654752f, 0.55557023301960218f, 0.38268343236508977f, 0.19509032201612825f};
    return cf{C[q], -S[q]};
}
__device__ __forceinline__ cf hy_conv_lds(const LAS bf16_t* row, float w0, float w1, float w2, float bias, int n) {
    cf r; const int nm = n - (n > 0 ? 1 : 0);
    { const LAS bf16_t* p = row;       float um = bf2f(p[nm]), u0 = bf2f(p[n]), up = bf2f(p[n + 1]); um = n > 0 ? um : 0.f; up = n < SEQ - 1 ? up : 0.f; r.x = w0 * um + w1 * u0 + w2 * up + bias; }
    { const LAS bf16_t* p = row + SEQ; float um = bf2f(p[nm]), u0 = bf2f(p[n]), up = bf2f(p[n + 1]); um = n > 0 ? um : 0.f; up = n < SEQ - 1 ? up : 0.f; r.y = w0 * um + w1 * u0 + w2 * up + bias; }
    return r;
}
__device__ __forceinline__ void hyena_taps(int c, int o, const float* __restrict__ KT, float (&f)[16], int tid) {
    const int hf = tid >> 8, tl = fft_launder(tid & 255);
    const float* krow = KT + (size_t)(o * 2 * 1024 + c) * SEQ;
#pragma unroll
    for (int q = 0; q < 16; ++q) { const int n = tl + 256 * q; const int pos = hf ? SEQ - n : n; f[q] = (pos < SEQ) ? krow[hf * (1024 * SEQ) + pos] : 0.f; }
}
__device__ __forceinline__ void hyena_kspec(const float (&f)[16], cf (&K)[16], LAS unsigned char* lds, const FftTw& w, int tid) {
    const int hf = tid >> 8, t = tid & 255, s1 = t + (t >> 4);
    LAS cf* buf = (LAS cf*)(lds + FFT_BUF_OFF + hf * FFT_BUF_BYTES);
    LAS cf* obuf = (LAS cf*)(lds + FFT_BUF_OFF + (1 - hf) * FFT_BUF_BYTES);
    LAS float* red = (LAS float*)(lds + FFT_RED_OFF);
    float l1 = 0.f;
#pragma unroll
    for (int q = 0; q < 16; ++q) { l1 += fabsf(f[q]); buf[s1 + 272 * q] = cf{f[q], 0.f}; }
    l1 = block_sum_512(l1, red);
    const cf w8o = fft_opaque(w.w8);
#pragma unroll
    for (int q = 0; q < 16; ++q) { const float mine = buf[s1 + 272 * q].x, other = obuf[s1 + 272 * q].x; const float fw = hf ? other : mine, bw = hf ? mine : other;
        if (hf == 0) K[q] = cf{fw + bw, 0.f};
        else { const cf w8 = cmul(w8o, w32_pow(q)); const float d = fw - bw; K[q] = cf{d * w8.x, d * w8.y}; } }
    blk_sync();
    fft4096_fwd(K, t, buf, w);
    blk_sync();
    const float sc = 1.0f / ((l1 + EPS) * 8192.0f);
#pragma unroll
    for (int p = 0; p < 16; ++p) K[p] *= sc;
}
__device__ __forceinline__ void hyena_rows(int c, const bf16_t* __restrict__ ZT, u32x4 (&rowreg)[6], int tid) {
    const int tl = fft_launder(tid);
#pragma unroll
    for (int rw = 0; rw < 3; ++rw) { const bf16_t* src = ZT + (size_t)(rw * 1024 + c) * MROWS;
#pragma unroll
        for (int jj = 0; jj < 2; ++jj) rowreg[rw * 2 + jj] = *(const u32x4*)(src + (jj * 512 + tl) * 8); }
}
__device__ __forceinline__ void hyena_item(int c, const bf16_t* __restrict__ ZT, const float* __restrict__ KT, const float* __restrict__ cw, const float* __restrict__ cb,
                                           const float* __restrict__ hbias, float* __restrict__ YBT, cf* __restrict__ kscr  , const cf* __restrict__ kpre  ,
                                           int c_next  , u32x4 (&rowreg)[6]  , LAS unsigned char* lds) {
    int tid_ = threadIdx.x;
#ifndef EMU
    asm volatile("" : "+v"(tid_));
#endif
    const int tid = tid_, hf = tid >> 8, t = tid & 255;
    const FftTw w = fft_make_tw(t);
    LAS cf* buf = (LAS cf*)(lds + FFT_BUF_OFF + hf * FFT_BUF_BYTES);
    LAS cf* obuf = (LAS cf*)(lds + FFT_BUF_OFF + (1 - hf) * FFT_BUF_BYTES);
    LAS float* red = (LAS float*)(lds + FFT_RED_OFF);
    LAS bf16_t* urow = (LAS bf16_t*)(lds + FFT_UROW_OFF);
    LAS cf* z1 = (LAS cf*)(lds + FFT_Z1_OFF);
    const int s1 = t + (t >> 4);
    const cf W32_1 = cf{0.98078528040323043f, -0.19509032201612825f};
    float ftap[16];
    if (!kpre) hyena_taps(c, 0, KT, ftap, tid);
#pragma unroll
    for (int rw = 0; rw < 3; ++rw)
#pragma unroll
        for (int jj = 0; jj < 2; ++jj) *(LAS u32x4*)(urow + rw * 2 * SEQ + (jj * 512 + tid) * 8) = rowreg[rw * 2 + jj];
    blk_sync();
    {
        const float vw0 = cw[c], vw1 = cw[3072 + c], vw2 = cw[2 * 3072 + c], vbb = cb[c];
#pragma unroll 1
        for (int q = hf * 8; q < hf * 8 + 8; ++q) { const int n = t + 256 * q; z1[n] = hy_conv_lds(urow, vw0, vw1, vw2, vbb, n); }
    }
    blk_sync();
#pragma unroll
    for (int o = 0; o < 2; ++o) {
        cf K[16];
        if (kpre) { const int tk = fft_launder(tid);
#pragma unroll
            for (int p = 0; p < 16; ++p) K[p] = kpre[(size_t)o * (16 * 512) + p * 512 + tk]; }
        else { hyena_kspec(ftap, K, lds, w, tid); if (o == 0) hyena_taps(c, 1, KT, ftap, tid); }
        {
            cf tw = fft_opaque(w.w8);
#pragma unroll 1
            for (int q = 0; q < 16; ++q) { const cf xv = z1[t + 256 * q]; buf[s1 + 272 * q] = hf ? cmul(xv, tw) : xv; tw = cmul(tw, W32_1); }
        }
        cf s[16];
#pragma unroll
        for (int q = 0; q < 16; ++q) s[q] = buf[s1 + 272 * q];
        fft4096_fwd(s, t, buf, w);
#pragma unroll
        for (int p = 0; p < 16; ++p) s[p] = cmul(s[p], K[p]);
        if (o == 1 && c_next >= 0) hyena_rows(c_next, ZT, rowreg, tid);
        fft4096_inv(s, t, buf, w);
        { const cf w8o = fft_opaque(w.w8);
#pragma unroll
          for (int q = 0; q < 16; ++q) { cf v = s[DFT16_T(q)]; if (hf) v = cmulc(v, cmul(w8o, w32_pow(q))); buf[s1 + 272 * q] = v; } }
        blk_sync();
        {
            const int ch = (o + 1) * 1024 + c;
            const float w0 = cw[ch], w1 = cw[3072 + ch], w2 = cw[2 * 3072 + ch], bb = cb[ch], hb = hbias[o * 1024 + c];
            float* yb = YBT + (size_t)c * MLAT;
#pragma unroll 1
            for (int q = hf * 8; q < hf * 8 + 8; ++q) { const int n = t + 256 * q; const cf y = buf[s1 + 272 * q] + obuf[s1 + 272 * q];
                const cf xv = z1[n];
                const cf xm = hy_conv_lds(urow + (o + 1) * 2 * SEQ, w0, w1, w2, bb, n);
                const cf res = xm * (y + hb * xv);
                if (o == 0) z1[n] = res;
                else { yb[n] = res.x; yb[SEQ + n] = res.y; } }
        }
        blk_sync();
    }
}
__device__ __forceinline__ void fourier_rows(int cp, const bf16_t* __restrict__ UCST, u32x4 (&rowreg)[4], int tid) {
    const int tl = fft_launder(tid);
#pragma unroll
    for (int rw = 0; rw < 2; ++rw) { const bf16_t* src = UCST + (size_t)(rw * 1024 + cp) * MROWS;
#pragma unroll
        for (int jj = 0; jj < 2; ++jj) rowreg[rw * 2 + jj] = *(const u32x4*)(src + (jj * 512 + tl) * 8); }
}
__device__ __forceinline__ void fourier_item(int cp, const bf16_t* __restrict__ UCST, bf16_t* __restrict__ YAT, int cp_next, u32x4 (&rowreg)[4]  , LAS unsigned char* lds, const FftTw& w) {
    const int tid = lnd(threadIdx.x), hf = tid >> 8, t = tid & 255;
    LAS cf* buf = (LAS cf*)(lds + FFT_BUF_OFF + hf * FFT_BUF_BYTES);
    LAS bf16_t* urow = (LAS bf16_t*)(lds + FFT_UROW_OFF);
#pragma unroll
    for (int rw = 0; rw < 2; ++rw)
#pragma unroll
        for (int jj = 0; jj < 2; ++jj) *(LAS u32x4*)(urow + rw * 2 * SEQ + (jj * 512 + tid) * 8) = rowreg[rw * 2 + jj];
    blk_sync();
    if (cp_next >= 0) fourier_rows(cp_next, UCST, rowreg, tid);
    cf x[16];
    { const LAS bf16_t* uc = urow + hf * SEQ + t; const LAS bf16_t* us = urow + 2 * SEQ + hf * SEQ + t;
#pragma unroll
      for (int q = 0; q < 16; ++q) x[q] = cf{bf2f(uc[256 * q]), -bf2f(us[256 * q])}; }
    fft4096_fwd(x, t, buf, w);
    blk_sync();
    LAS float* fb = (LAS float*)buf;
    const int f0 = (t >> 4) + 16 * (t & 15);
#pragma unroll
    for (int p = 0; p < 16; ++p) fb[f0 + 256 * p] = x[DFT16_T(p)].x * (1.0f / 1024.0f);
    blk_sync();
    { bf16_t* ya = YAT + (size_t)cp * MLAT + hf * SEQ;
#pragma unroll
      for (int jj = 0; jj < 2; ++jj) { const int n8 = (jj * 256 + fft_launder(t)) * 8; const f32x4 v0 = *(const LAS f32x4*)(fb + n8), v1 = *(const LAS f32x4*)(fb + n8 + 4);
          u32x4 o; o.x = (unsigned)f2bf(v0[0]) | ((unsigned)f2bf(v0[1]) << 16); o.y = (unsigned)f2bf(v0[2]) | ((unsigned)f2bf(v0[3]) << 16); o.z = (unsigned)f2bf(v1[0]) | ((unsigned)f2bf(v1[1]) << 16); o.w = (unsigned)f2bf(v1[2]) | ((unsigned)f2bf(v1[3]) << 16);
          *(u32x4*)(ya + n8) = o; } }
    blk_sync();
}
typedef short bf16x8 __attribute__((ext_vector_type(8)));
constexpr int NCHUNK = SEQP / 64;
constexpr int SC_PS = 72;
__device__ __forceinline__ int scan_chunk_map(int j, int dir) { return dir ? (j < 4 ? 3 - j : 71 - j) : j; }
__device__ __forceinline__ int ml_tok_row(int b, int p) { if (p < CTXL) return MLAT + b * CTXL + p; const int pp = p - CTXL; return b * SEQ + (pp & 63) * 64 + (pp >> 6); }
__device__ __forceinline__ int gla_tok_row(int b, int p) { return p < CTXL ? MLAT + b * CTXL + p : b * SEQ + p - CTXL; }
__device__ __forceinline__ unsigned pack_bf2(float lo, float hi) { return (unsigned)f2bf(lo) | ((unsigned)f2bf(hi) << 16); }

__device__ __forceinline__ void gate_scan_item(int seq, const float* __restrict__ ZG, const float* __restrict__ gate_b, float* __restrict__ LI, float* __restrict__ BG, float* __restrict__ MG, LAS unsigned char* lds) {
    const int tid = lnd(threadIdx.x), b = seq >> 3, h = (seq >> 1) & 3, dir = seq & 1;
    LAS float* tot = (LAS float*)lds; LAS float* mx = tot + 512;
    float li[9], bg[9]; float run = 0.f;
    const float bi = gate_b[dir * 8 + h], bf = gate_b[dir * 8 + 4 + h];
#pragma unroll
    for (int i = 0; i < 9; ++i) { const int p = tid * 9 + i; li[i] = 0.f; bg[i] = 0.f;
        if (p < SEQP) { const int pp = dir ? (p < CTXL ? CTXL - 1 - p : CTXL + SEQ - 1 - (p - CTXL)) : p; const size_t r = ml_tok_row(b, pp);
            li[i] = ZG[r * 256 + dir * 8 + h] + bi; run += logsigmoid_f(ZG[r * 256 + dir * 8 + 4 + h] + bf); bg[i] = run; } }
    const int lane = tid & 63, wv = tid >> 6;
    float inc = run;
#pragma unroll
    for (int d = 1; d < 64; d <<= 1) { const float o = __shfl_up(inc, d); if (lane >= d) inc += o; }
    if (lane == 63) tot[wv] = inc;
    blk_sync();
    float pre = inc - run;
    for (int u = 0; u < wv; ++u) pre += tot[u];
    float m = -3.0e38f;
#pragma unroll
    for (int i = 0; i < 9; ++i) { bg[i] += pre; const int p = tid * 9 + i; if (p < SEQP) m = fmaxf(m, li[i] - bg[i]); }
    float minc = m;
#pragma unroll
    for (int d = 1; d < 64; d <<= 1) { const float o = __shfl_up(minc, d); if (lane >= d) minc = fmaxf(minc, o); }
    if (lane == 63) mx[wv] = minc;
    blk_sync();
    float pm = 0.f;
    { const float ex = __shfl_up(minc, 1); if (lane >= 1) pm = fmaxf(pm, ex); }
    for (int u = 0; u < wv; ++u) pm = fmaxf(pm, mx[u]);
#pragma unroll
    for (int i = 0; i < 9; ++i) { const int p = tid * 9 + i; if (p < SEQP) { pm = fmaxf(pm, li[i] - bg[i]); LI[seq * SEQP + p] = li[i]; BG[seq * SEQP + p] = bg[i]; MG[seq * SEQP + p] = bg[i] + pm; } }
    blk_sync();
}

constexpr int S1_PQ = 264;
constexpr int S1_QB = 0, S1_KB = S1_QB + 64 * S1_PQ * 2, S1_KT = S1_KB + 64 * S1_PQ * 2, S1_SB = S1_KT + 256 * SC_PS * 2, S1_SC = S1_SB + 64 * SC_PS * 2, S1_LA = S1_SC + 2048, S1_LDS_BYTES = S1_LA + 64 * 128 * 4;
__device__ __forceinline__ void s1_copy_out(const LAS bf16_t* src, bf16_t* dst, int rows) {
    for (int e = lnd(threadIdx.x); e < rows * 8; e += 512) { const int r = e >> 3, c = e & 7; *(u32x4*)(dst + (size_t)r * 64 + c * 8) = *(const LAS u32x4*)(src + r * SC_PS + c * 8); }
}
template <bool ML> __device__ __forceinline__ void s1_vt(const bf16_t* __restrict__ Z, int zc, int b, int h, int jo, bf16_t* __restrict__ vt, LAS unsigned char* lds) {
    LAS bf16_t* T = (LAS bf16_t*)(lds + S1_QB);
    for (int e = lnd(threadIdx.x); e < 64 * 64; e += 512) { const int row = e >> 6, c4 = (e & 63) * 4; const int p = jo * 64 + row; const size_t r = ML ? ml_tok_row(b, p) : gla_tok_row(b, p);
        const u32x2 v = *(const u32x2*)(Z + r * NP + zc + h * 256 + c4);
        T[(c4 + 0) * SC_PS + row] = (bf16_t)(v.x & 0xffff); T[(c4 + 1) * SC_PS + row] = (bf16_t)(v.x >> 16); T[(c4 + 2) * SC_PS + row] = (bf16_t)(v.y & 0xffff); T[(c4 + 3) * SC_PS + row] = (bf16_t)(v.y >> 16); }
    blk_sync();
    s1_copy_out(T, vt, 256);
    blk_sync();
}
template <int KSTEPS> __device__ __forceinline__ void s1_qk(const LAS bf16_t* Qb, const LAS bf16_t* Kb, int w, int r, int q, f32x4 (&acc)[2]) {
#pragma unroll
    for (int ti = 0; ti < 2; ++ti) { const int id = 2 * w + ti, mt = id >> 2, nt = id & 3; acc[ti] = (f32x4){0.f, 0.f, 0.f, 0.f};
#pragma unroll
        for (int kk = 0; kk < KSTEPS; ++kk) { const bf16x8 a = *(const LAS bf16x8*)(Qb + (16 * mt + r) * S1_PQ + 32 * kk + 8 * q), bb = *(const LAS bf16x8*)(Kb + (16 * nt + r) * S1_PQ + 32 * kk + 8 * q);
            acc[ti] = __builtin_amdgcn_mfma_f32_16x16x32_bf16(a, bb, acc[ti], 0, 0, 0); } }
}
__device__ __forceinline__ void ml_s1_rows(int seq, int jo, const bf16_t* __restrict__ Z, u32x2 (&rq)[10], u32x2 (&rk)[10], int tid) {
    const int b = seq >> 3, h = (seq >> 1) & 3, hc = h * 256 + (tid & 63) * 4, row0 = (tid >> 6) * 8;
#pragma unroll
    for (int i = 0; i < 10; ++i) { const int pp = jo * 64 + row0 + i - 1;
        const int pc = pp < 0 ? 0 : (pp > SEQP - 1 ? SEQP - 1 : pp); const size_t tr = ml_tok_row(b, pc);
        rq[i] = *(const u32x2*)(Z + tr * NP + ZC_CQ + hc); rk[i] = *(const u32x2*)(Z + tr * NP + ZC_CK + hc); }
}
__device__ __forceinline__ void ml_s1_item(int seq, int jo, const float* __restrict__ cw  , const float* __restrict__ cb  , const bf16_t* __restrict__ Z, const float* __restrict__ LI, const float* __restrict__ BG, const float* __restrict__ MG,
                                           bf16_t* __restrict__ SP, bf16_t* __restrict__ QS, bf16_t* __restrict__ KST, float* __restrict__ DEC, float* __restrict__ CL, bf16_t* __restrict__ VT,
                                           int it_next  , u32x2 (&rq)[10], u32x2 (&rk)[10]  , LAS unsigned char* lds) {
    const int tid = lnd(threadIdx.x), w = tid >> 6, lane = tid & 63, r = lane & 15, q = lane >> 4;
    const int b = seq >> 3, h = (seq >> 1) & 3, dir = seq & 1, js = scan_chunk_map(jo, dir);
    LAS bf16_t* Qb = (LAS bf16_t*)(lds + S1_QB); LAS bf16_t* Kb = (LAS bf16_t*)(lds + S1_KB); LAS bf16_t* KT = (LAS bf16_t*)(lds + S1_KT); LAS bf16_t* Sb = (LAS bf16_t*)(lds + S1_SB);
    LAS float* at = (LAS float*)(lds + S1_SC); LAS float* as = at + 64; LAS float* wprev = at + 128; LAS float* wstate = at + 192;
    const size_t item = (size_t)seq * NCHUNK + jo;
    const int c4 = (tid & 63) * 4, hc = h * 256 + c4;
    const f32x4 wq0 = *(const f32x4*)(cw + hc), wq1 = *(const f32x4*)(cw + 1024 + hc), wq2 = *(const f32x4*)(cw + 2048 + hc), bq = *(const f32x4*)(cb + hc);
    const f32x4 wk0 = *(const f32x4*)(cw + 3072 + hc), wk1 = *(const f32x4*)(cw + 4096 + hc), wk2 = *(const f32x4*)(cw + 5120 + hc), bk = *(const f32x4*)(cb + 1024 + hc);
    const int row0 = (tid >> 6) * 8;
    if (tid < 64) {
        const int t = tid, ps = 64 * js + (dir ? 63 - t : t);
        const float* li = LI + seq * SEQP; const float* bg = BG + seq * SEQP; const float* mg = MG + seq * SEQP;
        const float Bt = bg[ps], Mt = mg[ps], lit = li[ps];
        const float Bs0 = js > 0 ? bg[64 * js - 1] : 0.f, Ms0 = js > 0 ? mg[64 * js - 1] : 0.f, Be = bg[64 * js + 63], Me = mg[64 * js + 63];
        at[t] = Bt - Mt; as[t] = lit - Bt; wprev[t] = fexp(Bt - Bs0 + Ms0 - Mt); wstate[t] = fexp(Be - Bt + lit - Me);
        CL[item * 64 + t] = fexp(-Mt);
        const float decay = fexp(Be - Bs0 + Ms0 - Me);
#pragma unroll
        for (int i = 0; i < 4; ++i) DEC[item * 256 + t * 4 + i] = decay;
    }
    blk_sync();
#pragma unroll
    for (int i = 0; i < 8; ++i) { const int row = row0 + i, pp = jo * 64 + row;
        const bool hasm = (pp != 0 && pp != CTXL), hasp = (pp != CTXL - 1 && pp != SEQP - 1);
        const float fm = hasm ? 1.f : 0.f, fp = hasp ? 1.f : 0.f;
        f32x4 qv, kv;
        { const u32x2 a = rq[i], c0 = rq[i + 1], d = rq[i + 2];
          const float am[4] = {__uint_as_float(a.x << 16), __uint_as_float(a.x & 0xffff0000u), __uint_as_float(a.y << 16), __uint_as_float(a.y & 0xffff0000u)};
          const float a0[4] = {__uint_as_float(c0.x << 16), __uint_as_float(c0.x & 0xffff0000u), __uint_as_float(c0.y << 16), __uint_as_float(c0.y & 0xffff0000u)};
          const float ap[4] = {__uint_as_float(d.x << 16), __uint_as_float(d.x & 0xffff0000u), __uint_as_float(d.y << 16), __uint_as_float(d.y & 0xffff0000u)};
#pragma unroll
          for (int j = 0; j < 4; ++j) qv[j] = silu_f(wq0[j] * am[j] * fm + wq1[j] * a0[j] + wq2[j] * ap[j] * fp + bq[j]); }
        { const u32x2 a = rk[i], c0 = rk[i + 1], d = rk[i + 2];
          const float am[4] = {__uint_as_float(a.x << 16), __uint_as_float(a.x & 0xffff0000u), __uint_as_float(a.y << 16), __uint_as_float(a.y & 0xffff0000u)};
          const float a0[4] = {__uint_as_float(c0.x << 16), __uint_as_float(c0.x & 0xffff0000u), __uint_as_float(c0.y << 16), __uint_as_float(c0.y & 0xffff0000u)};
          const float ap[4] = {__uint_as_float(d.x << 16), __uint_as_float(d.x & 0xffff0000u), __uint_as_float(d.y << 16), __uint_as_float(d.y & 0xffff0000u)};
#pragma unroll
          for (int j = 0; j < 4; ++j) kv[j] = silu_f(wk0[j] * am[j] * fm + wk1[j] * a0[j] + wk2[j] * ap[j] * fp + bk[j]) * 0.0625f; }
        u32x2 o; o.x = pack_bf2(qv[0], qv[1]); o.y = pack_bf2(qv[2], qv[3]); *(LAS u32x2*)(Qb + row * S1_PQ + c4) = o;
        o.x = pack_bf2(kv[0], kv[1]); o.y = pack_bf2(kv[2], kv[3]); *(LAS u32x2*)(Kb + row * S1_PQ + c4) = o;
        const float wp = wprev[row], ws = wstate[row];
        o.x = pack_bf2(qv[0] * wp, qv[1] * wp); o.y = pack_bf2(qv[2] * wp, qv[3] * wp); *(u32x2*)(QS + (item * 64 + row) * 256 + c4) = o;
#pragma unroll
        for (int j = 0; j < 4; ++j) KT[(c4 + j) * SC_PS + row] = f2bf(kv[j] * ws); }
    if (it_next >= 0) ml_s1_rows(it_next / NCHUNK, it_next % NCHUNK, Z, rq, rk, tid);
    blk_sync();
    f32x4 acc[2];
    s1_qk<8>(Qb, Kb, w, r, q, acc);
#pragma unroll
    for (int ti = 0; ti < 2; ++ti) { const int id = 2 * w + ti, mt = id >> 2, nt = id & 3, s = 16 * nt + r;
#pragma unroll
        for (int i = 0; i < 4; ++i) { const int t = 16 * mt + 4 * q + i; const bool valid = dir ? (s >= t) : (s <= t);
            Sb[t * SC_PS + s] = f2bf(valid ? acc[ti][i] * fexp(at[t] + as[s]) : 0.f); } }
    blk_sync();
    s1_copy_out(Sb, SP + item * 4096, 64);
    s1_copy_out(KT, KST + item * 256 * 64, 256);
    blk_sync();
    if (dir == 0) s1_vt<true>(Z, ZC_CV, b, h, jo, VT + ((size_t)(b * 4 + h) * NCHUNK + jo) * 256 * 64, lds);
}
__device__ __forceinline__ void gla_s1_item(int seq, int jo, const bf16_t* __restrict__ Z, const float* __restrict__ ZG, const float* __restrict__ w2, const float* __restrict__ b2,
                                            bf16_t* __restrict__ SP, bf16_t* __restrict__ QS, bf16_t* __restrict__ KST, float* __restrict__ DEC, bf16_t* __restrict__ VT, LAS unsigned char* lds) {
    const int tid = lnd(threadIdx.x), w = tid >> 6, lane = tid & 63, r = lane & 15, q = lane >> 4;
    const int b = seq >> 3, h = (seq >> 1) & 3, dir = seq & 1;
    LAS bf16_t* Qb = (LAS bf16_t*)(lds + S1_QB); LAS bf16_t* Kb = (LAS bf16_t*)(lds + S1_KB); LAS bf16_t* KT = (LAS bf16_t*)(lds + S1_KT); LAS bf16_t* Sb = (LAS bf16_t*)(lds + S1_SB);
    LAS float* LA = (LAS float*)(lds + S1_LA);
    LAS float* blast = (LAS float*)(lds + S1_SC);
    LAS float* a16 = (LAS float*)(lds + S1_KT);
    const size_t item = (size_t)seq * NCHUNK + jo;
    u32x2 pq[4], pk[4];
#pragma unroll
    for (int i = 0; i < 4; ++i) { const int e = i * 512 + tid, row = e >> 5, c4 = (e & 31) * 4; const size_t tr = gla_tok_row(b, jo * 64 + row);
        pq[i] = *(const u32x2*)(Z + tr * NP + ZC_DQ + h * 128 + c4); pk[i] = *(const u32x2*)(Z + tr * NP + ZC_DK + h * 128 + c4); }
    for (int e = tid; e < 64 * 16; e += 512) { const int t = e >> 4, rr = e & 15; const size_t tr = gla_tok_row(b, jo * 64 + t); a16[e] = ZG[tr * 256 + 16 + dir * 16 + rr]; }
    blk_sync();
    {
        const int k = tid & 127, tg = tid >> 7; float wr[16];
#pragma unroll
        for (int rr = 0; rr < 16; ++rr) wr[rr] = w2[(dir * 16 + rr) * 512 + h * 128 + k];
        const float bb = b2[dir * 512 + h * 128 + k];
        for (int t = tg * 16; t < tg * 16 + 16; ++t) { float x = bb;
#pragma unroll
            for (int rr = 0; rr < 16; ++rr) x += a16[t * 16 + rr] * wr[rr];
            LA[t * 128 + k] = logsigmoid_fast(x) * (1.0f / 16.0f); }
    }
    blk_sync();
    {
        const int k = tid & 127, sg = tid >> 7; float run = 0.f; float vals[16];
#pragma unroll
        for (int i = 0; i < 16; ++i) { const int si = sg * 16 + i, t = dir ? 63 - si : si; run += LA[t * 128 + k]; vals[i] = run; }
        LAS float* segs = blast + 128;
        if (sg < 3) segs[sg * 128 + k] = run;
        blk_sync();
        float off = 0.f;
#pragma unroll
        for (int u = 0; u < 3; ++u) off += (u < sg) ? segs[u * 128 + k] : 0.f;
#pragma unroll
        for (int i = 0; i < 16; ++i) { const int si = sg * 16 + i, t = dir ? 63 - si : si; LA[t * 128 + k] = vals[i] + off; }
        if (sg == 3) { const float tot = run + off; blast[k] = tot; DEC[item * 128 + k] = fexp(tot); }
    }
    blk_sync();
    const float qsc = 0.08838834764831845f;
#pragma unroll
    for (int i = 0; i < 4; ++i) { const int e = i * 512 + tid, row = e >> 5, c4 = (e & 31) * 4;
        const u32x2 qz = pq[i], kz = pk[i];
        float qv[4] = {__uint_as_float(qz.x << 16), __uint_as_float(qz.x & 0xffff0000u), __uint_as_float(qz.y << 16), __uint_as_float(qz.y & 0xffff0000u)};
        float kv[4] = {__uint_as_float(kz.x << 16), __uint_as_float(kz.x & 0xffff0000u), __uint_as_float(kz.y << 16), __uint_as_float(kz.y & 0xffff0000u)};
        float qd[4], q2[4], kd[4];
#pragma unroll
        for (int j = 0; j < 4; ++j) { const float bc = LA[row * 128 + c4 + j], bl = blast[c4 + j]; qd[j] = qv[j] * qsc * fexp(bc); q2[j] = qv[j] * qsc * fexp(bc - bl); kd[j] = kv[j] * fexp(bl - bc); }
        u32x2 o; o.x = pack_bf2(qd[0], qd[1]); o.y = pack_bf2(qd[2], qd[3]); *(u32x2*)(QS + (item * 64 + row) * 128 + c4) = o;
        o.x = pack_bf2(q2[0], q2[1]); o.y = pack_bf2(q2[2], q2[3]); *(LAS u32x2*)(Qb + row * S1_PQ + c4) = o;
        o.x = pack_bf2(kd[0], kd[1]); o.y = pack_bf2(kd[2], kd[3]); *(LAS u32x2*)(Kb + row * S1_PQ + c4) = o;
#pragma unroll
        for (int j = 0; j < 4; ++j) KT[(c4 + j) * SC_PS + row] = f2bf(kd[j]); }
    blk_sync();
    f32x4 acc[2];
    s1_qk<4>(Qb, Kb, w, r, q, acc);
#pragma unroll
    for (int ti = 0; ti < 2; ++ti) { const int id = 2 * w + ti, mt = id >> 2, nt = id & 3, s = 16 * nt + r;
#pragma unroll
        for (int i = 0; i < 4; ++i) { const int t = 16 * mt + 4 * q + i; const bool valid = dir ? (s >= t) : (s <= t); Sb[t * SC_PS + s] = f2bf(valid ? acc[ti][i] : 0.f); } }
    blk_sync();
    s1_copy_out(Sb, SP + item * 4096, 64);
    s1_copy_out(KT, KST + item * 128 * 64, 128);
    blk_sync();
    if (dir == 0) s1_vt<false>(Z, ZC_DV, b, h, jo, VT + ((size_t)(b * 4 + h) * NCHUNK + jo) * 256 * 64, lds);
}

__device__ __forceinline__ void lds_barrier() {
#ifndef EMU
    asm volatile("s_waitcnt lgkmcnt(0)\n\ts_barrier" ::: "memory");
#else
    __syncthreads();
#endif
}
template <int MODE> struct S2Cfg { static constexpr int DKK = MODE ? 128 : 256, NT = MODE ? 2 : 3, NSW = DKK / 32, PQ = DKK + 8;
    static constexpr int SPB = 0, QSB = SPB + 64 * SC_PS * 2, KSB = QSB + 64 * PQ * 2, VTB = KSB + DKK * SC_PS * 2, CBB = VTB + 32 * SC_PS * 2, DCB = CBB + NSW * NT * 64 * 16, CLB = DCB + DKK * 4, DNB = CLB + 256, LDS_BYTES = DNB + 256; };
template <int MODE> __device__ __forceinline__ void scan_item(int seq, int slice, const bf16_t* __restrict__ SP, const bf16_t* __restrict__ QS, const bf16_t* __restrict__ KST, const bf16_t* __restrict__ VT,
                                                              const float* __restrict__ DEC, const float* __restrict__ CL, float* __restrict__ OUT, LAS unsigned char* lds) {
    typedef S2Cfg<MODE> C;
    constexpr int DKK = C::DKK, NT = C::NT, NSW = C::NSW, PQ = C::PQ;
    const int tid = lnd(threadIdx.x), w = tid >> 6, lane = tid & 63, r = lane & 15, q = lane >> 4;
    const int b = seq >> 3, h = (seq >> 1) & 3, dir = seq & 1;
    LAS bf16_t* SPb = (LAS bf16_t*)(lds + C::SPB); LAS bf16_t* QSb = (LAS bf16_t*)(lds + C::QSB); LAS bf16_t* KSb = (LAS bf16_t*)(lds + C::KSB); LAS bf16_t* VTb = (LAS bf16_t*)(lds + C::VTB);
    LAS u32x4* CB = (LAS u32x4*)(lds + C::CBB); LAS float* dec = (LAS float*)(lds + C::DCB); LAS float* clamp = (LAS float*)(lds + C::CLB); LAS float* denb = (LAS float*)(lds + C::DNB);
    constexpr int NMT = DKK / 64;
    const bool outw = (w & 1) == 0; const int ow = w >> 1;
    f32x4 St[NMT][NT];
#pragma unroll
    for (int mi = 0; mi < NMT; ++mi)
#pragma unroll
        for (int nt = 0; nt < NT; ++nt) St[mi][nt] = (f32x4){0.f, 0.f, 0.f, 0.f};
    bf16x8 augf;
#pragma unroll
    for (int j = 0; j < 8; ++j) augf[j] = (short)(r == 0 ? 0x3F80 : 0);
    u32x4 rSP, rQS[DKK / 64], rKS[DKK / 64], rVT = {0u, 0u, 0u, 0u}; float rDEC = 0.f, rCL = 0.f;
    unsigned oQS[DKK / 64], oKS[DKK / 64];
#pragma unroll
    for (int i = 0; i < DKK / 64; ++i) { const int e = i * 512 + tid; oQS[i] = (unsigned)(((e / (DKK / 8)) * DKK + (e % (DKK / 8)) * 8) * 2); oKS[i] = (unsigned)(((e >> 3) * 64 + (e & 7) * 8) * 2); }
    const unsigned oSP = (unsigned)(((tid >> 3) * 64 + (tid & 7) * 8) * 2), oVT = (unsigned)((((slice * 32 + (tid >> 3)) * 64) + (tid & 7) * 8) * 2);
    const char* const vtb = (const char*)VT + (size_t)(b * 4 + h) * NCHUNK * 256 * 64 * 2;
#define S2_PREFETCH(JS) do { const int jo_ = scan_chunk_map((JS), dir); const unsigned item_ = (unsigned)(seq * NCHUNK + jo_); \
        const char* sp_ = (const char*)SP + (size_t)item_ * 8192; const char* qs_ = (const char*)QS + (size_t)item_ * (64 * DKK * 2); const char* ks_ = (const char*)KST + (size_t)item_ * (DKK * 64 * 2); \
        rSP = *(const u32x4*)(sp_ + oSP); \
        _Pragma("unroll") for (int i = 0; i < DKK / 64; ++i) { rQS[i] = *(const u32x4*)(qs_ + oQS[i]); rKS[i] = *(const u32x4*)(ks_ + oKS[i]); } \
        if (tid < 256) rVT = *(const u32x4*)(vtb + (size_t)jo_ * (256 * 64 * 2) + oVT); \
        if (tid < DKK) rDEC = DEC[item_ * DKK + tid]; \
        if (MODE == 0 && tid < 64) rCL = CL[item_ * 64 + tid]; } while (0)
    S2_PREFETCH(0);
#pragma unroll 1
    for (int js = 0; js < NCHUNK; ++js) {
        const int jo = scan_chunk_map(js, dir);
        lds_barrier();
        *(LAS u32x4*)(SPb + (tid >> 3) * SC_PS + (tid & 7) * 8) = rSP;
#pragma unroll
        for (int i = 0; i < DKK / 64; ++i) { const int e = i * 512 + tid; *(LAS u32x4*)(QSb + (e / (DKK / 8)) * PQ + (e % (DKK / 8)) * 8) = rQS[i]; *(LAS u32x4*)(KSb + (e >> 3) * SC_PS + (e & 7) * 8) = rKS[i]; }
        if (tid < 256) *(LAS u32x4*)(VTb + (tid >> 3) * SC_PS + (tid & 7) * 8) = rVT;
        if (tid < DKK) dec[tid] = rDEC;
        if (MODE == 0 && tid < 64) clamp[tid] = rCL;
        if (!outw) {
#pragma unroll
            for (int kl = 0; kl < NMT / 2; ++kl)
#pragma unroll
                for (int nt = 0; nt < NT; ++nt) { u32x4 f; f.x = pack_bf2(St[2 * kl][nt][0], St[2 * kl][nt][1]); f.y = pack_bf2(St[2 * kl][nt][2], St[2 * kl][nt][3]);
                    f.z = pack_bf2(St[2 * kl + 1][nt][0], St[2 * kl + 1][nt][1]); f.w = pack_bf2(St[2 * kl + 1][nt][2], St[2 * kl + 1][nt][3]);
                    CB[((ow * (NMT / 2) + kl) * NT + nt) * 64 + lane] = f; }
        }
        lds_barrier();
        if (js + 1 < NCHUNK) S2_PREFETCH(js + 1);
        if (outw) {
            f32x4 oacc[NT];
#pragma unroll
            for (int nt = 0; nt < NT; ++nt) oacc[nt] = (f32x4){0.f, 0.f, 0.f, 0.f};
#pragma unroll
            for (int kk = 0; kk < NSW; ++kk) { const LAS bf16_t* ap = QSb + (16 * ow + r) * PQ + 32 * kk + 4 * q;
                const u32x2 a0 = *(const LAS u32x2*)ap, a1 = *(const LAS u32x2*)(ap + 16); u32x4 au; au.x = a0.x; au.y = a0.y; au.z = a1.x; au.w = a1.y;
#pragma unroll
                for (int nt = 0; nt < NT; ++nt) { const u32x4 bu = CB[(kk * NT + nt) * 64 + lane];
                    oacc[nt] = __builtin_amdgcn_mfma_f32_16x16x32_bf16(__builtin_bit_cast(bf16x8, au), __builtin_bit_cast(bf16x8, bu), oacc[nt], 0, 0, 0); } }
#pragma unroll
            for (int ks = 0; ks < 2; ++ks) { const bf16x8 a = *(const LAS bf16x8*)(SPb + (16 * ow + r) * SC_PS + 32 * ks + 8 * q);
#pragma unroll
                for (int nt = 0; nt < NT; ++nt) { const bf16x8 bb = (MODE == 0 && nt == 2) ? augf : *(const LAS bf16x8*)(VTb + (16 * nt + r) * SC_PS + 32 * ks + 8 * q);
                    oacc[nt] = __builtin_amdgcn_mfma_f32_16x16x32_bf16(a, bb, oacc[nt], 0, 0, 0); } }
            const bool isctx = jo < 4;
            const int rowA = isctx ? MLAT + b * CTXL + jo * 64 : (MODE ? b * SEQ + (jo - 4) * 64 : b * SEQ + (jo - 4));
            const int tmul = (MODE == 0 && !isctx) ? 64 : 1;
            float* const obase = OUT + ((size_t)dir * MROWS + rowA) * 1024 + h * 256 + slice * 32;
#pragma unroll
            for (int i = 0; i < 4; ++i) { const int t = 16 * ow + 4 * q + i;
                float sc = 1.0f;
                if (MODE == 0) { const float den = __shfl(oacc[NT - 1][i], lane & 48); sc = frcp(fmaxf(fabsf(den), clamp[t])); }
#pragma unroll
                for (int nt = 0; nt < 2; ++nt) obase[(unsigned)(t * tmul * 1024 + 16 * nt + r)] = oacc[nt][i] * sc; }
        } else {
#pragma unroll
            for (int mi = 0; mi < NMT; ++mi) { const int mtile = ow * NMT + mi;
                bf16x8 a[2];
#pragma unroll
                for (int ks = 0; ks < 2; ++ks) a[ks] = *(const LAS bf16x8*)(KSb + (16 * mtile + r) * SC_PS + 32 * ks + 8 * q);
#pragma unroll
                for (int nt = 0; nt < NT; ++nt) {
#pragma unroll
                    for (int i = 0; i < 4; ++i) St[mi][nt][i] *= dec[16 * mtile + 4 * q + i];
#pragma unroll
                    for (int ks = 0; ks < 2; ++ks) { const bf16x8 bb = (MODE == 0 && nt == 2) ? augf : *(const LAS bf16x8*)(VTb + (16 * nt + r) * SC_PS + 32 * ks + 8 * q);
                        St[mi][nt] = __builtin_amdgcn_mfma_f32_16x16x32_bf16(a[ks], bb, St[mi][nt], 0, 0, 0); } } }
        }
    }
    blk_sync();
#undef S2_PREFETCH
}
#define XB_TMO      128
#define XB_XCNT(j)  (256  + 64 * (j))
#define XB_XSUB(j)  (1280 + 64 * (j))
#define XB_XGEN(j)  (2304 + 64 * (j))
#define XB_TOP      3328
#define XB_TOPGEN   3392
#define XCD_BAR_WORDS 3456
#define XB_SPIN_CAP (1u << 18)

__device__ __forceinline__ unsigned xb_ld(unsigned* p)              { return __hip_atomic_load(p, __ATOMIC_RELAXED, __HIP_MEMORY_SCOPE_AGENT); }
__device__ __forceinline__ unsigned xb_add(unsigned* p, unsigned v) { return __hip_atomic_fetch_add(p, v, __ATOMIC_RELAXED, __HIP_MEMORY_SCOPE_AGENT); }
__device__ __forceinline__ unsigned xb_xcc_id() { return (unsigned)__builtin_amdgcn_s_getreg((3 << 11) | 20) & 0xFu; }
#define XB_SPIN(cond, bar) do { unsigned _sp = 0; while (cond) { __builtin_amdgcn_s_sleep(1); \
    if ((++_sp & 255u) == 0u) { if (xb_ld(&(bar)[XB_TMO])) break; if (_sp > XB_SPIN_CAP) { atomicAdd(&(bar)[XB_TMO], 1u); break; } } } } while (0)

struct XcdBarrier {
    unsigned* bar; unsigned x;
    volatile LAS unsigned* st;
};

__device__ __forceinline__ XcdBarrier xcd_barrier_post(unsigned* bar, volatile LAS unsigned* st) {
    XcdBarrier b; b.bar = bar; b.x = xb_xcc_id(); b.st = st;
    if (threadIdx.x == 0) (void)xb_add(&bar[XB_XCNT(b.x)], 1u);
    return b;
}
__device__ __forceinline__ void xcd_barrier_complete(unsigned* bar, unsigned x, unsigned& nloc, unsigned& nx) {
    const unsigned G = gridDim.x * gridDim.y * gridDim.z;
    unsigned sum, cnt, mine, sp = 0u;
    for (;;) {
        sum = 0u; cnt = 0u; mine = 0u;
#pragma unroll
        for (unsigned j = 0; j < 16; ++j) { const unsigned c = xb_ld(&bar[XB_XCNT(j)]); sum += c; cnt += (c > 0u) ? 1u : 0u; mine = (j == x) ? c : mine; }
        if (sum == G) break;
        __builtin_amdgcn_s_sleep(1);
        if ((++sp & 255u) == 0u) { if (xb_ld(&bar[XB_TMO])) break; if (sp > XB_SPIN_CAP) { atomicAdd(&bar[XB_TMO], 1u); break; } }
    }
    nloc = mine > 0u ? mine : 1u; nx = cnt > 0u ? cnt : 1u;
}

__device__ __forceinline__ void xcd_barrier(const XcdBarrier& b) {
    asm volatile("s_waitcnt vmcnt(0)" ::: "memory");
    __syncthreads();
    if (threadIdx.x == 0) {
        unsigned* bar = b.bar;
        __builtin_amdgcn_s_waitcnt(0);
        unsigned nloc = b.st[0], nx = b.st[1];
        if (nloc == 0u) { xcd_barrier_complete(bar, b.x, nloc, nx); b.st[0] = nloc; b.st[1] = nx; }
        const unsigned old = xb_add(&bar[XB_XSUB(b.x)], 1u);
        const unsigned gen = old / nloc;
        if (old + 1u == (gen + 1u) * nloc) {
            __builtin_amdgcn_fence(__ATOMIC_RELEASE, "agent");
            asm volatile("s_waitcnt vmcnt(0)" ::: "memory");
            const unsigned og = xb_add(&bar[XB_TOP], 1u);
            const unsigned tg = og / nx;
            if (og + 1u == (tg + 1u) * nx) xb_add(&bar[XB_TOPGEN], 1u);
            else XB_SPIN(xb_ld(&bar[XB_TOPGEN]) == tg, bar);
            __builtin_amdgcn_fence(__ATOMIC_ACQUIRE, "agent");
            xb_add(&bar[XB_XGEN(b.x)], 1u);
            asm volatile("s_waitcnt vmcnt(0)" ::: "memory");
        } else {
            XB_SPIN(xb_ld(&bar[XB_XGEN(b.x)]) == gen, bar);
            __builtin_amdgcn_fence(__ATOMIC_ACQUIRE, "agent");
            asm volatile("s_waitcnt vmcnt(0)" ::: "memory");
        }
    }
    __syncthreads();
}
#define MP_FIELDS(X) \
X(const float*, x) X(const float*, c) X(const float*, ctx) X(const float*, c_ctx) X(const float*, ada_w) X(const float*, ada_b) X(const float*, norm_g) X(const float*, w_in) X(const float*, fnet_w) X(const float*, hy_conv_w) X(const float*, hy_conv_b) X(const float*, hy_f_w1) X(const float*, hy_f_b1) X(const float*, hy_f_w2) X(const float*, hy_f_b2) X(const float*, hy_f_w3) X(const float*, hy_f_freq) X(const float*, hy_bias) X(const float*, ml_conv_w) X(const float*, ml_conv_b) X(const float*, ml_gate_b) X(const float*, gla_w2) X(const float*, gla_b2) X(const float*, gla_norm_g) X(const float*, w_out) X(const float*, final_g) \
 X(float*, out) X(unsigned*, bar) \
X(bf16_t*, wint) X(bf16_t*, woutt) X(bf16_t*, fnett) X(bf16_t*, H) X(bf16_t*, Z) X(bf16_t*, ZT) X(bf16_t*, YCAT) X(bf16_t*, YA) X(bf16_t*, YAT) X(bf16_t*, CST) X(bf16_t*, WA) X(bf16_t*, HB) X(bf16_t*, HBC) X(bf16_t*, SPm) X(bf16_t*, SPg) X(bf16_t*, QSm) X(bf16_t*, QSg) X(bf16_t*, KSTm) X(bf16_t*, KSTg) X(bf16_t*, VTm) X(bf16_t*, VTg) X(bf16_t*, UCST) \
X(float*, adapart) X(float*, mod) X(float*, ZG) X(float*, X1) X(float*, KT) X(float*, KTC) X(float*, YBT) X(float*, LI) X(float*, BG) X(float*, MG) X(float*, DECm) X(float*, DECg) X(float*, CLm) X(float*, OM) X(float*, OG) X(float*, KSCR) X(float*, KPRE) X(float*, PART)
struct MP {
#define MP_DECL(T, f) T f;
    MP_FIELDS(MP_DECL)
#undef MP_DECL
    int ph_begin, ph_end;
};
__device__ __forceinline__ const void* mp_rfl(const LAS void* const* slot) {
    const unsigned long long v = *(const LAS unsigned long long*)slot;
    const unsigned lo = __builtin_amdgcn_readfirstlane((unsigned)v), hi = __builtin_amdgcn_readfirstlane((unsigned)(v >> 32));
    typedef __attribute__((address_space(1))) const void* gptr_t;
    return (const void*)(gptr_t)(((unsigned long long)hi << 32) | lo);
}
__device__ __forceinline__ MP mp_load(const LAS MP* lp) {
    MP q; asm volatile("" ::: "memory");
#define MP_LD(T, f) q.f = (T)mp_rfl((const LAS void* const*)&lp->f);
    MP_FIELDS(MP_LD)
#undef MP_LD
    q.ph_begin = 0; q.ph_end = 0; return q;
}
constexpr int MEGA_BARW_OFF = 152704;
constexpr int MEGA_PAR_OFF = 152720;
constexpr int MEGA_LDS_BYTES = 153344;

struct WTile { const float* src; bf16_t* dst; int K, srcN, n0, k0; bool map; };
__device__ __forceinline__ void wtile_load(const WTile& w, f32x4 (&v)[8], int tid) {
#pragma unroll
    for (int it = 0; it < 8; ++it) { const int i = it * 512 + tid, kk = i >> 4, n4 = (i & 15) * 4; const int sn = w.map ? win_colmap(w.n0 + n4) : w.n0 + n4;
        v[it] = (f32x4){0.f, 0.f, 0.f, 0.f}; if (sn >= 0) v[it] = *(const f32x4*)(w.src + (size_t)(w.k0 + kk) * w.srcN + sn); }
}
__device__ __forceinline__ void wtile_to_lds(const f32x4 (&v)[8], LAS float* tile, int tid) {
#pragma unroll
    for (int it = 0; it < 8; ++it) { const int i = it * 512 + tid, kk = i >> 4, n4 = (i & 15) * 4;
        tile[kk * 65 + n4] = v[it][0]; tile[kk * 65 + n4 + 1] = v[it][1]; tile[kk * 65 + n4 + 2] = v[it][2]; tile[kk * 65 + n4 + 3] = v[it][3]; }
}
__device__ __forceinline__ void wtile_store(const WTile& w, const LAS float* tile, int tid) {
    const int nl = tid & 15, kl = (tid >> 4) & 3, wv = tid >> 6;
#pragma unroll
    for (int it = 0; it < 4; ++it) { const int bi = it * 8 + wv, nn = (bi & 3) * 16 + nl, k8 = ((bi >> 2) * 4 + kl) * 8;
        u32x4 o; o.x = pack_bf2(tile[k8 * 65 + nn], tile[(k8 + 1) * 65 + nn]); o.y = pack_bf2(tile[(k8 + 2) * 65 + nn], tile[(k8 + 3) * 65 + nn]);
        o.z = pack_bf2(tile[(k8 + 4) * 65 + nn], tile[(k8 + 5) * 65 + nn]); o.w = pack_bf2(tile[(k8 + 6) * 65 + nn], tile[(k8 + 7) * 65 + nn]);
        *(u32x4*)(w.dst + (size_t)(w.n0 + nn) * w.K + w.k0 + k8) = o; }
}
__device__ __forceinline__ void ada_item(int item, const MP& p, LAS float* s) {
    const int tid = lnd(threadIdx.x), cb = item % 6, ks = (item / 6) % ADA_KS, layer = item / (6 * ADA_KS);
    constexpr int KC = D / ADA_KS;
    const int k0 = ks * KC;
    if (tid < 3 * KC) { const int v = tid / KC, kk = tid % KC; const float xv = v < 2 ? p.c[v * D + k0 + kk] : p.c_ctx[k0 + kk]; s[tid] = silu_f(xv); }
    blk_sync();
    const float* w = p.ada_w + (size_t)layer * D * 3 * D + (size_t)k0 * 3 * D + cb * 2048 + tid * 4;
    f32x4 a0 = {0, 0, 0, 0}, a1 = {0, 0, 0, 0}, a2 = {0, 0, 0, 0};
#pragma unroll 8
    for (int kk = 0; kk < KC; ++kk) { const f32x4 wv = *(const f32x4*)(w + (size_t)kk * 3 * D); a0 += s[kk] * wv; a1 += s[KC + kk] * wv; a2 += s[2 * KC + kk] * wv; }
    float* q = p.adapart + ((size_t)(layer * ADA_KS + ks) * 3) * 3 * D + cb * 2048 + tid * 4;
    *(f32x4*)(q) = a0; *(f32x4*)(q + 3 * D) = a1; *(f32x4*)(q + 2 * 3 * D) = a2;
    blk_sync();
}
__device__ __forceinline__ void hid_item(int item, const MP& p, LAS float* sm) {
    const int tid = lnd(threadIdx.x), j = tid & 63, pl = tid >> 6;
    constexpr int PER = (SEQ + CTXL) / 8;
    const int layer = item / PER, rem = item % PER; const bool isctx = rem >= SEQ / 8; const int L = isctx ? CTXL : SEQ; const int pos = (isctx ? rem - SEQ / 8 : rem) * 8 + pl;
    LAS float* feats = sm + pl * 40; LAS float* h1 = sm + 320 + pl * 64;
    const float* w1 = p.hy_f_w1 + layer * 33 * 64; const float* b1 = p.hy_f_b1 + layer * 64; const float* w2 = p.hy_f_w2 + layer * 64 * 64; const float* b2 = p.hy_f_b2 + layer * 64; const float* fr = p.hy_f_freq + layer * 128;
    if (j < 33) {
        if (j == 0) feats[0] = (float)((double)pos / (double)(L - 1));
        else { const int i = (j - 1) & 15; const float band = 1e-4f + (float)i * ((15.0f - 1e-4f) / 15.0f);
            const float rev = (float)pos * band / (float)L;
            feats[j] = j <= 16 ? hw_cos_rev(rev) : -hw_sin_rev(rev); }
    }
    blk_sync();
    float a = b1[j];
    for (int i = 0; i < 33; ++i) a += feats[i] * w1[i * 64 + j];
    h1[j] = sinf(fr[j] * a);
    blk_sync();
    float a2 = b2[j];
    for (int i = 0; i < 64; ++i) a2 += h1[i] * w2[i * 64 + j];
    const float hv = sinf(fr[64 + j] * a2);
    const bf16_t hi = f2bf(hv), lo = f2bf(hv - bf2f(hi));
    bf16_t* row = (isctx ? p.HBC + ((size_t)layer * CTXL + pos) * 256 : p.HB + ((size_t)layer * SEQ + pos) * 256);
    row[j] = hi; row[64 + j] = hi; row[128 + j] = lo; row[192 + j] = 0;
    blk_sync();
}
__device__ __forceinline__ void pro_elem(int idx, const MP& p) {
    if (idx < 2 * 64 * 4096) {
        const int layer = idx / (64 * 4096), rem = idx % (64 * 4096), i = rem / 4096, col = rem % 4096;
        const float wv = p.hy_f_w3[(size_t)layer * 64 * 4096 + rem]; const bf16_t hi = f2bf(wv), lo = f2bf(wv - bf2f(hi));
        bf16_t* row = p.WA + ((size_t)layer * 4096 + col) * 256; row[i] = hi; row[64 + i] = lo; row[128 + i] = hi; row[192 + i] = 0;
    } else { const int e = idx - 2 * 64 * 4096;
        if (e < 512 * 256) { const int m = e >> 8, cc = e & 255, part = m >> 8, cp = m & 255; float s, c; sincospif(2.0f * (float)((cc * cp) & 255) / 256.0f, &s, &c); p.CST[e] = f2bf(part ? s : c); } }
}
constexpr int PRO_ELEMS = 2 * 64 * 4096 + 512 * 256;

__device__ __forceinline__ float half_block_sum(float v, LAS float* red) {
    for (int o = 32; o > 0; o >>= 1) v += __shfl_xor(v, o);
    const int t_ = lnd(threadIdx.x), w = t_ >> 6;
    lds_sync();
    if ((t_ & 63) == 0) red[w] = v;
    lds_sync();
    const int h4 = (w >> 2) * 4;
    return (red[h4] + red[h4 + 1]) + (red[h4 + 2] + red[h4 + 3]);
}
__device__ __forceinline__ f32x4 bf4_to_f32(u32x2 u) { return (f32x4){__uint_as_float(u.x << 16), __uint_as_float(u.x & 0xffff0000u), __uint_as_float(u.y << 16), __uint_as_float(u.y & 0xffff0000u)}; }
__device__ __forceinline__ void norm_phase(int layer, int blk, int G, const MP& p, LAS float* red) {
    const int t_ = lnd(threadIdx.x), tid = t_ & 255, half = t_ >> 8;
    const float* g = p.norm_g + layer * D;
    const bf16_t* P0 = (const bf16_t*)p.X1;
    f32x4 nx[4]; u32x2 np[4];
#pragma unroll
    for (int i = 0; i < 4; ++i) np[i] = (u32x2){0u, 0u};
    const float* gate0c = p.mod + 2 * 3 * D + 2 * D;
#define NORM_LOAD(IT) do { const int r_ = (IT) * 2 + half; \
        if (layer == 1 && r_ >= MLAT) { const size_t rc_ = (size_t)(r_ - MLAT) * D; \
            _Pragma("unroll") for (int i = 0; i < 4; ++i) { const int cc_ = i * 1024 + tid * 4; f32x4 s_ = *(const f32x4*)(p.PART + rc_ + cc_); \
                _Pragma("unroll") for (int ks = 1; ks < 8; ++ks) s_ += *(const f32x4*)(p.PART + (size_t)ks * MCTX * D + rc_ + cc_); \
                nx[i] = *(const f32x4*)(p.ctx + rc_ + cc_) + *(const f32x4*)(gate0c + cc_) * s_; } } \
        else { const float* xr_ = r_ < MLAT ? p.x + (size_t)r_ * D : p.ctx + (size_t)(r_ - MLAT) * D; \
            _Pragma("unroll") for (int i = 0; i < 4; ++i) nx[i] = *(const f32x4*)(xr_ + i * 1024 + tid * 4); \
            if (layer == 1) { _Pragma("unroll") for (int i = 0; i < 4; ++i) np[i] = *(const u32x2*)(P0 + (size_t)r_ * D + i * 1024 + tid * 4); } } } while (0)
    if (blk < MROWS / 2) NORM_LOAD(blk);
    for (int it = blk; it < MROWS / 2; it += G) {
        const int r = it * 2 + half, v = r < MLAT ? r / SEQ : 2;
        const float* shift = p.mod + (size_t)layer * 9 * D + v * 3 * D; const float* scale = shift + D;
        f32x4 xv[4]; float ss = 0.f;
#pragma unroll
        for (int i = 0; i < 4; ++i) { xv[i] = nx[i];
            if (layer == 1 && r < MLAT) xv[i] += *(const f32x4*)(p.mod + v * 3 * D + 2 * D + i * 1024 + tid * 4) * bf4_to_f32(np[i]);
            ss += xv[i][0] * xv[i][0] + xv[i][1] * xv[i][1] + xv[i][2] * xv[i][2] + xv[i][3] * xv[i][3]; }
        if (it + G < MROWS / 2) NORM_LOAD(it + G);
        ss = half_block_sum(ss, red);
        const float rs = rsqrtf(ss * (1.f / D) + EPS);
#pragma unroll
        for (int i = 0; i < 4; ++i) { const int cc = i * 1024 + tid * 4;
            const f32x4 gg = *(const f32x4*)(g + cc), sc = *(const f32x4*)(scale + cc), sh = *(const f32x4*)(shift + cc);
            const f32x4 y = xv[i] * rs * gg * (1.f + sc) + sh;
            u32x2 o; o.x = pack_bf2(y[0], y[1]); o.y = pack_bf2(y[2], y[3]); *(u32x2*)(p.H + (size_t)r * D + cc) = o; }
    }
#undef NORM_LOAD
}
__device__ __forceinline__ void final_phase(int blk, int G, const MP& p, LAS float* red) {
    const int t_ = lnd(threadIdx.x), tid = t_ & 255, half = t_ >> 8;
    const bf16_t* P0 = (const bf16_t*)p.X1; const bf16_t* P1 = P0 + (size_t)MLAT * D;
    f32x4 nx[4]; u32x2 n0[4], n1[4];
#define FIN_LOAD(IT) do { const size_t ro_ = (size_t)((IT) * 2 + half) * D; _Pragma("unroll") for (int i = 0; i < 4; ++i) { const int cc_ = i * 1024 + tid * 4; \
        nx[i] = *(const f32x4*)(p.x + ro_ + cc_); n0[i] = *(const u32x2*)(P0 + ro_ + cc_); n1[i] = *(const u32x2*)(P1 + ro_ + cc_); } } while (0)
    if (blk < MLAT / 2) FIN_LOAD(blk);
    for (int it = blk; it < MLAT / 2; it += G) {
        const int r = it * 2 + half, v = r / SEQ;
        const float* ga0 = p.mod + v * 3 * D + 2 * D; const float* ga1 = p.mod + 9 * D + v * 3 * D + 2 * D;
        f32x4 xv[4]; float ss = 0.f;
#pragma unroll
        for (int i = 0; i < 4; ++i) { const int cc = i * 1024 + tid * 4; xv[i] = nx[i] + *(const f32x4*)(ga0 + cc) * bf4_to_f32(n0[i]) + *(const f32x4*)(ga1 + cc) * bf4_to_f32(n1[i]);
            ss += xv[i][0] * xv[i][0] + xv[i][1] * xv[i][1] + xv[i][2] * xv[i][2] + xv[i][3] * xv[i][3]; }
        if (it + G < MLAT / 2) FIN_LOAD(it + G);
        ss = half_block_sum(ss, red);
        const float rs = rsqrtf(ss * (1.f / D) + EPS);
#pragma unroll
        for (int i = 0; i < 4; ++i) { const int cc = i * 1024 + tid * 4; *(f32x4*)(p.out + (size_t)r * D + cc) = xv[i] * rs * *(const f32x4*)(p.final_g + cc); }
    }
#undef FIN_LOAD
}
__device__ __forceinline__ void combine_phase(int first, int stride, int nitems, int layer, const MP& p) {
    const int t_ = lnd(threadIdx.x), tid = t_ & 255, cc = tid * 4, half = t_ >> 8;
    const f32x4 gn = *(const f32x4*)(p.gla_norm_g + layer * 1024 + cc);
    f32x4 nom0, nom1, nog0, nog1; u32x2 nco, ncg, ndg;
#define CMB_LOAD(IT) do { const size_t r_ = (size_t)(IT) * 2 + half; \
        nom0 = *(const f32x4*)(p.OM + r_ * 1024 + cc); nom1 = *(const f32x4*)(p.OM + ((size_t)MROWS + r_) * 1024 + cc); nog0 = *(const f32x4*)(p.OG + r_ * 1024 + cc); nog1 = *(const f32x4*)(p.OG + ((size_t)MROWS + r_) * 1024 + cc); \
        nco = *(const u32x2*)(p.Z + r_ * NP + ZC_CO + cc); ncg = *(const u32x2*)(p.Z + r_ * NP + ZC_CG + cc); ndg = *(const u32x2*)(p.Z + r_ * NP + ZC_DG + cc); } while (0)
    if (first < nitems) CMB_LOAD(first);
    for (int it = first; it < nitems; it += stride) {
        const size_t r = (size_t)it * 2 + half;
        const f32x4 om = nom0 + nom1, og = nog0 + nog1; const u32x2 co = nco, cg = ncg, dg = ndg;
        if (it + stride < nitems) CMB_LOAD(it + stride);
        float ss = og[0] * og[0] + og[1] * og[1] + og[2] * og[2] + og[3] * og[3];
        for (int o = 32; o > 0; o >>= 1) ss += __shfl_xor(ss, o);
        const float rs = rsqrtf(ss * (1.f / 256.f) + EPS);
        const float cov[4] = {__uint_as_float(co.x << 16), __uint_as_float(co.x & 0xffff0000u), __uint_as_float(co.y << 16), __uint_as_float(co.y & 0xffff0000u)};
        const float cgv[4] = {__uint_as_float(cg.x << 16), __uint_as_float(cg.x & 0xffff0000u), __uint_as_float(cg.y << 16), __uint_as_float(cg.y & 0xffff0000u)};
        const float dgv[4] = {__uint_as_float(dg.x << 16), __uint_as_float(dg.x & 0xffff0000u), __uint_as_float(dg.y << 16), __uint_as_float(dg.y & 0xffff0000u)};
        float yc[4], yd[4];
#pragma unroll
        for (int j = 0; j < 4; ++j) { yc[j] = om[j] * sigmoid_f(cov[j]) * silu_f(cgv[j]); yd[j] = og[j] * rs * gn[j] * silu_f(dgv[j]); }
        u32x2 w; w.x = pack_bf2(yc[0], yc[1]); w.y = pack_bf2(yc[2], yc[3]); *(u32x2*)(p.YCAT + r * D + 2048 + cc) = w;
        w.x = pack_bf2(yd[0], yd[1]); w.y = pack_bf2(yd[2], yd[3]); *(u32x2*)(p.YCAT + r * D + 3072 + cc) = w;
    }
#undef CMB_LOAD
}
template <int MODE> __device__ __forceinline__ void tr_out_phase(int first, int stride, int count, const MP& p, LAS float* tile) {
    const int tid = lnd(threadIdx.x);
    f32x4 nv[2]; u32x4 ngz = {0u, 0u, 0u, 0u};
#define TRO_LOAD(ID) do { const int r0_ = ((ID) >> 4) * 64, c0_ = ((ID) & 15) * 64; \
        _Pragma("unroll") for (int it = 0; it < 2; ++it) { const int i = it * 512 + tid, cc = i >> 4, r4 = (i & 15) * 4; \
            if (MODE) nv[it] = *(const f32x4*)(p.YBT + (size_t)(c0_ + cc) * MLAT + r0_ + r4); \
            else { const u32x2 u = *(const u32x2*)(p.YAT + (size_t)(c0_ + cc) * MLAT + r0_ + r4); nv[it] = (f32x4){__uint_as_float(u.x << 16), __uint_as_float(u.x & 0xffff0000u), __uint_as_float(u.y << 16), __uint_as_float(u.y & 0xffff0000u)}; } } \
        if (MODE) ngz = *(const u32x4*)(p.Z + (size_t)(r0_ + (tid >> 3)) * NP + ZC_BG + c0_ + (tid & 7) * 8); } while (0)
    if (first < count) TRO_LOAD(first);
    for (int id = first; id < count; id += stride) {
        const int r0 = (id >> 4) * 64, c0 = (id & 15) * 64;
#pragma unroll
        for (int it = 0; it < 2; ++it) { const int i = it * 512 + tid, cc = i >> 4, r4 = (i & 15) * 4;
            tile[cc * 65 + r4] = nv[it][0]; tile[cc * 65 + r4 + 1] = nv[it][1]; tile[cc * 65 + r4 + 2] = nv[it][2]; tile[cc * 65 + r4 + 3] = nv[it][3]; }
        const u32x4 gz = ngz;
        lds_sync();
        if (id + stride < count) TRO_LOAD(id + stride);
        { const int rr = tid >> 3, c8 = (tid & 7) * 8; const size_t r = r0 + rr; float v[8];
#pragma unroll
          for (int j = 0; j < 8; ++j) v[j] = tile[(c8 + j) * 65 + rr];
          if (MODE) {
              const float gv[8] = {__uint_as_float(gz.x << 16), __uint_as_float(gz.x & 0xffff0000u), __uint_as_float(gz.y << 16), __uint_as_float(gz.y & 0xffff0000u), __uint_as_float(gz.z << 16), __uint_as_float(gz.z & 0xffff0000u), __uint_as_float(gz.w << 16), __uint_as_float(gz.w & 0xffff0000u)};
#pragma unroll
              for (int j = 0; j < 8; ++j) v[j] *= silu_f(gv[j]); }
          u32x4 o; o.x = pack_bf2(v[0], v[1]); o.y = pack_bf2(v[2], v[3]); o.z = pack_bf2(v[4], v[5]); o.w = pack_bf2(v[6], v[7]);
          if (MODE) *(u32x4*)(p.YCAT + r * D + 1024 + c0 + c8) = o; else *(u32x4*)(p.YA + r * 1024 + c0 + c8) = o; }
        lds_sync();
    }
#undef TRO_LOAD
    __syncthreads();
}
__device__ __forceinline__ void hyena_ctx_item(int c, int layer, const MP& p, LAS float* sm) {
    const int tid = lnd(threadIdx.x), b = tid >> 8, t = tid & 255;
    LAS float* kb = sm; LAS float* vb = sm + 512; LAS float* red = sm + 1024;
    const float* cw = p.hy_conv_w + (size_t)layer * 3 * 3072; const float* cb = p.hy_conv_b + layer * 3072; const float* hbias = p.hy_bias + layer * 2048;
    const float* KTC = p.KTC + (size_t)layer * 4096 * CTXL;
    float xc[3];
#pragma unroll
    for (int i = 0; i < 3; ++i) { const int ch = i * 1024 + c; const bf16_t* row = p.ZT + (size_t)ch * MROWS + MLAT + b * CTXL;
        const float um = t > 0 ? bf2f(row[t - 1]) : 0.f, u0 = bf2f(row[t]), up = t < CTXL - 1 ? bf2f(row[t + 1]) : 0.f;
        xc[i] = cw[ch] * um + cw[3072 + ch] * u0 + cw[2 * 3072 + ch] * up + cb[ch]; }
    float xin = xc[0];
    float kvo[2];
#pragma unroll
    for (int o = 0; o < 2; ++o) { kvo[o] = 0.f; if (tid < CTXL) kvo[o] = KTC[(size_t)((o * 2) * 1024 + c) * CTXL + tid]; else if (tid > CTXL) kvo[o] = KTC[(size_t)((o * 2 + 1) * 1024 + c) * CTXL + (2 * CTXL - tid)]; }
    const size_t r = MLAT + b * CTXL + t;
    const bf16_t gate = p.Z[r * NP + ZC_BG + c];
#pragma unroll
    for (int o = 0; o < 2; ++o) {
        const float kv = kvo[o];
        float l1 = fabsf(kv);
        for (int oo = 32; oo > 0; oo >>= 1) l1 += __shfl_xor(l1, oo);
        blk_sync();
        if ((tid & 63) == 0) red[tid >> 6] = l1;
        kb[(tid + CTXL) & (2 * CTXL - 1)] = kv; vb[tid] = xin;
        blk_sync();
        const float nrm = ((red[0] + red[1]) + (red[2] + red[3])) + ((red[4] + red[5]) + (red[6] + red[7])) + EPS;
        float y = 0.f;
#pragma unroll 16
        for (int s = 0; s < CTXL; ++s) y += vb[b * CTXL + s] * kb[CTXL + t - s];
        xin = xc[o + 1] * (y * frcp(nrm) + hbias[o * 1024 + c] * xin);
    }
    p.YCAT[r * D + 1024 + c] = f2bf(xin * silu_f(bf2f(gate)));
    blk_sync();
}
__device__ __forceinline__ void fourier_ctx_item(int cp, const MP& p, LAS float* sm) {
    const int tid = lnd(threadIdx.x), b = tid >> 8, lp = tid & 255;
    LAS float* uc = sm; LAS float* us = sm + 512; LAS float* cs = sm + 1024; LAS float* sn = sm + 1280;
    uc[tid] = bf2f(p.UCST[(size_t)cp * MROWS + MLAT + tid]); us[tid] = bf2f(p.UCST[(size_t)(1024 + cp) * MROWS + MLAT + tid]);
    if (tid < 256) { const float rv = (float)tid * (1.0f / 256.0f); cs[tid] = hw_cos_rev(rv); sn[tid] = hw_sin_rev(rv); }
    blk_sync();
    float y = 0.f; const float cw = cs[lp], sw = sn[lp];
    const LAS float* ucb = uc + b * CTXL; const LAS float* usb = us + b * CTXL;
#pragma unroll 1
    for (int l0 = 0; l0 < CTXL; l0 += 32) { const int idx = (l0 * lp) & 255; float c = cs[idx], s = sn[idx];
#pragma unroll
        for (int j = 0; j < 32; ++j) { y += c * ucb[l0 + j] - s * usb[l0 + j]; const float cn = c * cw - s * sw; s = c * sw + s * cw; c = cn; } }
    p.YA[(size_t)(MLAT + b * CTXL + lp) * 1024 + cp] = f2bf(y * (1.0f / 256.0f));
    blk_sync();
}

struct InProjSched : pg8::StaticOrder {
    __device__ bool next(int i, pg8::Unit& u) const { if (!pg8::StaticOrder::next(i, u)) return false;
        if (u.pn >= ZC_BU / 256 && u.pn < ZC_BG / 256) { u.aux = 1; const char* t = u.a; u.a = u.b; u.b = t; } else u.aux = (u.pn == NTN_IN - 1) ? 2 : 0; return true; }
};
#ifndef CTXU
#define CTXU 15
#endif
struct InProjSchedLast : InProjSched {
    static constexpr int NLAT = (MLAT / 256) * NTN_IN, NCTX = (MCTX / 256) * CTXU;
    __device__ bool next(int i, pg8::Unit& u) const { const long L = (long)i * G + c; if (L >= NLAT + NCTX) return false;
        const int w = (int)L;
        if (w < NLAT) { u.pn = w % NTN_IN; u.pm = w / NTN_IN; }
        else { const int jj = w - NLAT, j = jj % CTXU; u.pm = MLAT / 256 + jj / CTXU;
            u.pn = CTXU == 57 ? j : (j < 4 ? ZC_CK / 256 + j : j < 8 ? ZC_CV / 256 + (j - 4) : j < 10 ? ZC_DK / 256 + (j - 8) : j < 14 ? ZC_DV / 256 + (j - 10) : NTN_IN - 1); }
        u.a = A + (size_t)u.pm * tsA; u.b = B + (size_t)u.pn * tsB;
        if (u.pn >= ZC_BU / 256 && u.pn < ZC_BG / 256) { u.aux = 1; const char* t = u.a; u.a = u.b; u.b = t; } else u.aux = (u.pn == NTN_IN - 1) ? 2 : 0; return true; }
};
#ifdef PROBE_L2GEMM
struct ProbeSched : pg8::StaticOrder {
    __device__ bool next(int i, pg8::Unit& u) const { if (!pg8::StaticOrder::next(i, u)) return false; u.a = A; u.b = B; u.aux = 0; return true; }
};
struct EpiProbe {
    static constexpr bool PERM = true, AFTER_DRAIN = false;
    float* sink;
    __device__ __forceinline__ void operator()(const f32x4 (&acc)[2][2][4][2], const pg8::Unit& u, int wr, int wc, int fr, int fq) const {
        float s = 0.f;
#pragma unroll
        for (int ai = 0; ai < 2; ++ai)
#pragma unroll
            for (int bj = 0; bj < 2; ++bj)
#pragma unroll
                for (int m = 0; m < 4; ++m)
#pragma unroll
                    for (int n = 0; n < 2; ++n) s += acc[ai][bj][m][n][0] + acc[ai][bj][m][n][1] + acc[ai][bj][m][n][2] + acc[ai][bj][m][n][3];
        if (s == 1.2345678e33f) sink[0] = s;
    }
};
#endif
struct EpiInProj2 {
    static constexpr bool PERM = true, AFTER_DRAIN = false;
    bf16_t* Z; bf16_t* ZT; float* ZG;
    __device__ __forceinline__ void operator()(const f32x4 (&acc)[2][2][4][2], const pg8::Unit& u, int wr, int wc, int fr, int fq) const {
        if (u.aux == 2) { const int row0 = u.pm * 256 + wr * 64 + fr, col0 = wc * 32 + 8 * fq;
#pragma unroll
            for (int ai = 0; ai < 2; ++ai)
#pragma unroll
                for (int m = 0; m < 4; ++m) { float* rowp = ZG + (size_t)(row0 + ai * 128 + m * 16) * 256 + col0;
#pragma unroll
                    for (int bj = 0; bj < 2; ++bj) { *(f32x4*)(rowp + bj * 128) = acc[ai][bj][m][0]; *(f32x4*)(rowp + bj * 128 + 4) = acc[ai][bj][m][1]; } }
            return; }
        const int rt = u.aux ? u.pn : u.pm, ct = u.aux ? u.pm : u.pn;
        bf16_t* base = u.aux ? ZT - (size_t)ZC_BU * MROWS : Z; const size_t ld = u.aux ? MROWS : NP;
        const int row0 = rt * 256 + wr * 64 + fr, col0 = ct * 256 + wc * 32 + 8 * fq;
#pragma unroll
        for (int ai = 0; ai < 2; ++ai)
#pragma unroll
            for (int m = 0; m < 4; ++m) { bf16_t* rowp = base + (size_t)(row0 + ai * 128 + m * 16) * ld + col0;
#pragma unroll
                for (int bj = 0; bj < 2; ++bj) { const f32x4 v0 = acc[ai][bj][m][0], v1 = acc[ai][bj][m][1];
                    u32x4 w; w.x = pg8::cvt_pk_bf16(v0[0], v0[1]); w.y = pg8::cvt_pk_bf16(v0[2], v0[3]); w.z = pg8::cvt_pk_bf16(v1[0], v1[1]); w.w = pg8::cvt_pk_bf16(v1[2], v1[3]);
                    *(u32x4*)(rowp + bj * 128) = w; } }
    }
};
struct EpiOut2 {
    static constexpr bool PERM = true, AFTER_DRAIN = false;
    bf16_t* P;
    __device__ __forceinline__ void operator()(const f32x4 (&acc)[2][2][4][2], const pg8::Unit& u, int wr, int wc, int fr, int fq) const {
        const int row0 = u.pm * 256 + wr * 64 + fr, col0 = u.pn * 256 + wc * 32 + 8 * fq;
#pragma unroll
        for (int ai = 0; ai < 2; ++ai)
#pragma unroll
            for (int m = 0; m < 4; ++m) { bf16_t* rowp = P + (size_t)(row0 + ai * 128 + m * 16) * D + col0;
#pragma unroll
                for (int bj = 0; bj < 2; ++bj) { const f32x4 v0 = acc[ai][bj][m][0], v1 = acc[ai][bj][m][1];
                    u32x4 w; w.x = pg8::cvt_pk_bf16(v0[0], v0[1]); w.y = pg8::cvt_pk_bf16(v0[2], v0[3]); w.z = pg8::cvt_pk_bf16(v1[0], v1[1]); w.w = pg8::cvt_pk_bf16(v1[2], v1[3]);
                    *(u32x4*)(rowp + bj * 128) = w; } }
    }
};
struct EpiFnet2 {
    static constexpr bool PERM = true, AFTER_DRAIN = false;
    const bf16_t* Z; bf16_t* ycat;
    __device__ __forceinline__ void operator()(const f32x4 (&acc)[2][2][4][2], const pg8::Unit& u, int wr, int wc, int fr, int fq) const {
        const int row0 = u.pm * 256 + wr * 64 + fr, col0 = u.pn * 256 + wc * 32 + 8 * fq;
#pragma unroll
        for (int ai = 0; ai < 2; ++ai)
#pragma unroll
            for (int m = 0; m < 4; ++m) { const int r = row0 + ai * 128 + m * 16;
#pragma unroll
                for (int bj = 0; bj < 2; ++bj) { const int cc = col0 + bj * 128;
                    const u32x4 gz = *(const u32x4*)(Z + (size_t)r * NP + ZC_AG + cc);
                    const float gv[8] = {__uint_as_float(gz.x << 16), __uint_as_float(gz.x & 0xffff0000u), __uint_as_float(gz.y << 16), __uint_as_float(gz.y & 0xffff0000u), __uint_as_float(gz.z << 16), __uint_as_float(gz.z & 0xffff0000u), __uint_as_float(gz.w << 16), __uint_as_float(gz.w & 0xffff0000u)};
                    const f32x4 v0 = acc[ai][bj][m][0], v1 = acc[ai][bj][m][1];
                    u32x4 w; w.x = pg8::cvt_pk_bf16(v0[0] * silu_f(gv[0]), v0[1] * silu_f(gv[1])); w.y = pg8::cvt_pk_bf16(v0[2] * silu_f(gv[2]), v0[3] * silu_f(gv[3]));
                    w.z = pg8::cvt_pk_bf16(v1[0] * silu_f(gv[4]), v1[1] * silu_f(gv[5])); w.w = pg8::cvt_pk_bf16(v1[2] * silu_f(gv[6]), v1[3] * silu_f(gv[7]));
                    *(u32x4*)(ycat + (size_t)r * D + cc) = w; } }
    }
};
struct CtxSplitSched {
    int G, c; const char* A; const char* B;
    __device__ bool next(int i, pg8::Unit& u) const { const long Lx = (long)i * G + c; if (Lx >= 256) return false;
        const int pn = (int)Lx & 15, pm2 = ((int)Lx >> 4) & 1, ks = (int)Lx >> 5; u.pm = pm2; u.pn = pn; u.aux = ks;
        u.a = A + ((size_t)(MLAT / 256 + pm2) * 256 * D + ks * 512) * 2; u.b = B + ((size_t)pn * 256 * D + ks * 512) * 2; return true; }
    __device__ __forceinline__ void a_ready(const pg8::Unit&) const {}
    __device__ __forceinline__ void done(const pg8::Unit&) const {}
};
struct EpiCtxPart {
    static constexpr bool PERM = true, AFTER_DRAIN = false;
    float* PART;
    __device__ __forceinline__ void operator()(const f32x4 (&acc)[2][2][4][2], const pg8::Unit& u, int wr, int wc, int fr, int fq) const {
        const int row0 = u.pm * 256 + wr * 64 + fr, col0 = u.pn * 256 + wc * 32 + 8 * fq;
        float* base = PART + (size_t)u.aux * MCTX * D;
#pragma unroll
        for (int ai = 0; ai < 2; ++ai)
#pragma unroll
            for (int m = 0; m < 4; ++m) { float* rowp = base + (size_t)(row0 + ai * 128 + m * 16) * D + col0;
#pragma unroll
                for (int bj = 0; bj < 2; ++bj) { *(f32x4*)(rowp + bj * 128) = acc[ai][bj][m][0]; *(f32x4*)(rowp + bj * 128 + 4) = acc[ai][bj][m][1]; } }
    }
};
struct EpiFilt {
    static constexpr bool PERM = true, AFTER_DRAIN = false;
    float* KT; int L;
    __device__ __forceinline__ void operator()(const f32x4 (&acc)[2][2][4][2], const pg8::Unit& u, int wr, int wc, int fr, int fq) const {
        const int row0 = u.pm * 256 + wr * 64 + fr, col0 = u.pn * 256 + wc * 32 + 8 * fq;
        const float inv = 1.0f / (float)(L - 1);
#pragma unroll
        for (int ai = 0; ai < 2; ++ai)
#pragma unroll
            for (int m = 0; m < 4; ++m) { const int col = row0 + ai * 128 + m * 16; const float delta = fabsf(HY_SLOW + (HY_FAST - HY_SLOW) * ((float)(col & 1023) / 1023.0f));
#pragma unroll
                for (int bj = 0; bj < 2; ++bj)
#pragma unroll
                    for (int n = 0; n < 2; ++n) { const int pos = col0 + bj * 128 + 4 * n; f32x4 o;
#pragma unroll
                        for (int j = 0; j < 4; ++j) o[j] = acc[ai][bj][m][n][j] * fexp(-(float)(pos + j) * inv * delta);
                        *(f32x4*)(KT + (size_t)col * L + pos) = o; } }
    }
};
struct ChDftSched {
    int G, c; const char* A; const char* Zb; int nt;
    __device__ bool next(int i, pg8::Unit& u) const { const long Lx = (long)i * G + c; if (Lx >= 4 * 2 * nt) return false;
        const int g = (int)(Lx / (2 * nt)), rem = (int)(Lx % (2 * nt)); u.pm = rem & 1; u.pn = rem >> 1; u.aux = g;
        u.a = A + (size_t)u.pm * 256 * 256 * 2; u.b = Zb + ((size_t)u.pn * 256 * NP + ZC_AU + g * 256) * 2; return true; }
    __device__ __forceinline__ void a_ready(const pg8::Unit&) const {}
    __device__ __forceinline__ void done(const pg8::Unit&) const {}
};
struct EpiChDft {
    static constexpr bool PERM = true, AFTER_DRAIN = false;
    bf16_t* UCST;
    __device__ __forceinline__ void operator()(const f32x4 (&acc)[2][2][4][2], const pg8::Unit& u, int wr, int wc, int fr, int fq) const {
        const int cp0 = wr * 64 + fr, col0 = u.pn * 256 + wc * 32 + 8 * fq;
#pragma unroll
        for (int ai = 0; ai < 2; ++ai)
#pragma unroll
            for (int m = 0; m < 4; ++m) { const int orow = u.pm * 1024 + u.aux * 256 + cp0 + ai * 128 + m * 16;
#pragma unroll
                for (int bj = 0; bj < 2; ++bj) { const f32x4 v0 = acc[ai][bj][m][0], v1 = acc[ai][bj][m][1];
                    u32x4 w; w.x = pg8::cvt_pk_bf16(v0[0], v0[1]); w.y = pg8::cvt_pk_bf16(v0[2], v0[3]); w.z = pg8::cvt_pk_bf16(v1[0], v1[1]); w.w = pg8::cvt_pk_bf16(v1[2], v1[3]);
                    *(u32x4*)(UCST + (size_t)orow * MROWS + col0 + bj * 128) = w; } }
    }
};
constexpr int NPHASE = 17;
constexpr int NPRE = 0;
#ifndef STAGGER
#define STAGGER 7
#endif
#ifndef FILT_IN_TAIL
#define FILT_IN_TAIL 1
#endif
#ifndef CTX_RM
#define CTX_RM 1
#endif
#ifndef PH_MASK
#define PH_MASK 0x1FFFF
#endif
#ifndef MIX1_MASK
#define MIX1_MASK 31
#endif
#define M1_EN(x) (((MIX1_MASK) >> (x)) & 1)
#ifndef M1REP_MASK
#define M1REP_MASK 0
#endif
#define M1_REPS(x) ((((M1REP_MASK) >> (x)) & 1) ? (REP_N) : 1)
#ifndef REP_MASK
#define REP_MASK 0
#endif
#ifndef REP_N
#define REP_N 1
#endif
#define PH_REPS(x) ((((REP_MASK) >> (x)) & 1) ? (REP_N) : 1)
#define PH_EN(x) (((PH_MASK) >> (x)) & 1)
template <class Epi, class Sched> __device__ __forceinline__ void run_gemm(LAS unsigned char* lds, const pg8::Gemm& g, const Sched& S, const Epi& E) {
    pg8::gemm_phase<Epi, Sched, false>((PG8_LAS unsigned char*)lds, g, S, E, nullptr);
    __syncthreads();
}
constexpr int T_IN = (NP / 64) * (D / 256), T_OUT = (D / 64) * (D / 256), T_FN = (GW / 64) * (GW / 256), T_L = T_IN + T_OUT + T_FN;
__device__ __forceinline__ WTile pro_wtile_desc(int r, int l, const MP& p) {
    WTile w;
    if (r < T_IN) { w.src = p.w_in + (size_t)l * D * PROJ_W; w.dst = p.wint + (size_t)l * NP * D; w.K = D; w.srcN = PROJ_W; w.n0 = (r % (NP / 64)) * 64; w.k0 = (r / (NP / 64)) * 256; w.map = true; }
    else if ((r -= T_IN) < T_OUT) { w.src = p.w_out + (size_t)l * D * D; w.dst = p.woutt + (size_t)l * D * D; w.K = D; w.srcN = D; w.n0 = (r % (D / 64)) * 64; w.k0 = (r / (D / 64)) * 256; w.map = false; }
    else { r -= T_OUT; w.src = p.fnet_w + (size_t)l * GW * GW; w.dst = p.fnett + (size_t)l * GW * GW; w.K = GW; w.srcN = GW; w.n0 = (r % (GW / 64)) * 64; w.k0 = (r / (GW / 64)) * 256; w.map = false; }
    return w;
}
__device__ __forceinline__ void pro_wtiles(int base, int first, int stride, int count, int l, const MP& p, LAS float* ldsf) {
    const int tid = lnd(threadIdx.x);
    f32x4 va[8], vb[8];
    if (first < count) { const WTile w0 = pro_wtile_desc(base + first, l, p); wtile_load(w0, va, tid); }
    if (first + stride < count) { const WTile w1 = pro_wtile_desc(base + first + stride, l, p); wtile_load(w1, vb, tid); }
    for (int it = first; it < count; it += 2 * stride) {
        {
            const WTile w = pro_wtile_desc(base + it, l, p);
            wtile_to_lds(va, ldsf, tid);
            lds_sync();
            if (it + 2 * stride < count) { const WTile wn = pro_wtile_desc(base + it + 2 * stride, l, p); wtile_load(wn, va, tid); }
            wtile_store(w, ldsf, tid);
            lds_sync();
        }
        if (it + stride < count) {
            const WTile w = pro_wtile_desc(base + it + stride, l, p);
            wtile_to_lds(vb, ldsf, tid);
            lds_sync();
            if (it + 3 * stride < count) { const WTile wn = pro_wtile_desc(base + it + 3 * stride, l, p); wtile_load(wn, vb, tid); }
            wtile_store(w, ldsf, tid);
            lds_sync();
        }
    }
    __syncthreads();
}
__device__ __forceinline__ void tail_share(int nwg, int G, int blk, int& first, int& stride) {
    const int rem = nwg % G;
    if (rem == 0) { first = blk; stride = G; } else if (blk >= rem) { first = blk - rem; stride = G - rem; } else { first = 0x3fffffff; stride = 1; }
}
__device__ __forceinline__ void mod_final(int layer, int blk, int G, int tid, const MP& p) {
    for (int j = blk * 512 + lnd(tid); j < 9 * D; j += G * 512) { const int i = layer * 9 * D + j, n = j % (3 * D), v = j / (3 * D);
        float a = p.ada_b[layer * 3 * D + n];
        for (int ks = 0; ks < ADA_KS; ++ks) a += p.adapart[((size_t)(layer * ADA_KS + ks) * 3 + v) * 3 * D + n];
        p.mod[i] = a; }
}
__device__ __forceinline__ void filter_gemm(int l, bool with_ctx, LAS unsigned char* lds, int blk, int G, const MP& p) {
    { pg8::Gemm g{p.WA + (size_t)l * 4096 * 256, p.HB + (size_t)l * SEQ * 256, 4096, SEQ, 256, 256, 256, 0}; pg8::StaticOrder S; S.init(g, G, blk); EpiFilt E{p.KT + (size_t)l * 4096 * SEQ, SEQ}; run_gemm(lds, g, S, E); }
    if (with_ctx) { pg8::Gemm g{p.WA + (size_t)l * 4096 * 256, p.HBC + (size_t)l * CTXL * 256, 4096, CTXL, 256, 256, 256, 0}; pg8::StaticOrder S; S.init(g, G, blk); EpiFilt E{p.KTC + (size_t)l * 4096 * CTXL, CTXL}; run_gemm(lds, g, S, E); }
}
template <int l> __device__ __forceinline__ void layer_phases(const LAS MP* lp, LAS unsigned char* lds, LAS float* ldsf, const XcdBarrier& bar, int pb, int pe, int tid, int blk, int G) {
    constexpr int ph0 = 2 + 7 * l; constexpr bool last = (l == 1);
#define PHASE_ON(ph) (PH_EN(ph) && (ph) >= pb && (ph) < pe)
#define PHASE_SYNC(ph) do { if ((ph) >= pb && (ph) + 1 < pe) xcd_barrier(bar); } while (0)

        if (PHASE_ON(ph0)) for (int rep_ = 0; rep_ < PH_REPS(ph0); ++rep_) { const MP p = mp_load(lp); norm_phase(l, blk, G, p, ldsf); }
        PHASE_SYNC(ph0);
#ifdef PROBE_L2GEMM
        if (PHASE_ON(ph0 + 1)) { const MP p = mp_load(lp); pg8::Gemm g{p.H, p.wint + (size_t)l * NP * D, MROWS, NP, D, D, D, 0};
#if PROBE_L2GEMM == 1
            ProbeSched S;
#else
            InProjSched S;
#endif
            S.init(g, G, blk); EpiProbe E{p.KSCR}; run_gemm(lds, g, S, E); }
#endif
        if (PHASE_ON(ph0 + 1)) for (int rep_ = 0; rep_ < PH_REPS(ph0 + 1); ++rep_) { const MP p = mp_load(lp); pg8::Gemm g{p.H, p.wint + (size_t)l * NP * D, MROWS, NP, D, D, D, 0}; InProjSched S; S.init(g, G, blk); EpiInProj2 E{p.Z, p.ZT, p.ZG};
            if (l == 1 && CTX_RM) { InProjSchedLast S3; S3.init(g, G, blk); run_gemm(lds, g, S3, E); } else
            run_gemm(lds, g, S, E);
            if (l == 0) { int f0, st; tail_share((MROWS / 256) * NTN_IN, G, blk, f0, st);
                pro_wtiles(T_IN, f0, st, T_OUT + T_FN, 1, p, ldsf);
                for (int it = f0; it < ADA_KS * 6; it += st) ada_item(ADA_KS * 6 + it, p, ldsf);
                for (int it = f0; it < (SEQ + CTXL) / 8; it += st) hid_item((SEQ + CTXL) / 8 + it, p, ldsf); }
            if (l == 1 && FILT_IN_TAIL) { int f0, st; tail_share(CTX_RM ? InProjSchedLast::NLAT + InProjSchedLast::NCTX : (MROWS / 256) * NTN_IN, G, blk, f0, st);
                if (f0 < st) filter_gemm(1, false, lds, f0, st, p); }
            if (l == 1) { int f0, st; tail_share((MROWS / 256) * NTN_IN, G, blk, f0, st);
                for (int c = f0; c < NPRE; c += st) { const int t_ = lnd(tid); const FftTw w = fft_make_tw(t_ & 255);
                    for (int o = 0; o < 2; ++o) { cf Kr[16]; float fr[16]; hyena_taps(c, o, p.KT + (size_t)l * 4096 * SEQ, fr, t_); hyena_kspec(fr, Kr, lds, w, t_); cf* dst = (cf*)p.KPRE + ((size_t)c * 2 + o) * 16 * 512;
#pragma unroll
                        for (int pp = 0; pp < 16; ++pp) dst[pp * 512 + t_] = Kr[pp]; __syncthreads(); } } } }
        PHASE_SYNC(ph0 + 1);
        if (PHASE_ON(ph0 + 2)) for (int rep_ = 0; rep_ < PH_REPS(ph0 + 2); ++rep_) { const MP p = mp_load(lp);
            for (int r1_ = 0; r1_ < M1_REPS(0); ++r1_) if (M1_EN(0)) { pg8::Gemm g{p.CST, p.Z, 512, MROWS, 256, 256, NP, 0}; ChDftSched S; S.G = G; S.c = blk; S.nt = last ? MLAT / 256 : MROWS / 256; S.A = (const char*)p.CST; S.Zb = (const char*)p.Z; EpiChDft E{p.UCST}; run_gemm(lds, g, S, E); }
            for (int r1_ = 0; r1_ < M1_REPS(1); ++r1_) if (M1_EN(1)) { u32x4 rr[6]; if (blk < 1024) hyena_rows(blk, p.ZT, rr, lnd(tid));
                for (int c = blk; c < 1024; c += G) hyena_item(c, p.ZT, p.KT + (size_t)l * 4096 * SEQ, p.hy_conv_w + (size_t)l * 3 * 3072, p.hy_conv_b + l * 3072, p.hy_bias + l * 2048, p.YBT, (cf*)p.KSCR + (size_t)blk * 16 * 512,
                                                               (l == 1 && c < NPRE) ? (const cf*)p.KPRE + (size_t)c * 2 * 16 * 512 : nullptr, c + G < 1024 ? c + G : -1, rr, lds); }
            for (int r1_ = 0; r1_ < M1_REPS(2); ++r1_) if (M1_EN(2) && !last) { for (int c = blk; c < 1024; c += G) hyena_ctx_item(c, l, p, ldsf); }
            for (int r1_ = 0; r1_ < M1_REPS(3); ++r1_) if (M1_EN(3)) for (int s = G - 1 - blk; s >= 0 && s < 16; s += G) gate_scan_item(s, p.ZG, p.ml_gate_b + l * 16, p.LI, p.BG, p.MG, lds);
            for (int r1_ = 0; r1_ < M1_REPS(4); ++r1_) if (M1_EN(4)) for (int it = (blk + G / 2) % G; it < 16 * NCHUNK; it += G) gla_s1_item(it / NCHUNK, it % NCHUNK, p.Z, p.ZG, p.gla_w2 + (size_t)l * 2 * 16 * 512, p.gla_b2 + l * 1024, p.SPg, p.QSg, p.KSTg, p.DECg, p.VTg, lds);
        }
        PHASE_SYNC(ph0 + 2);
        if (PHASE_ON(ph0 + 3)) for (int rep_ = 0; rep_ < PH_REPS(ph0 + 3); ++rep_) { const MP p = mp_load(lp);
            const bool tr_first = (STAGGER & 2) && (((blk >> 3) & 1) != 0);
            constexpr int NTR = (MLAT / 64) * 16, NX5 = 16 * NCHUNK - 4 * 256; const bool trb = (G == 256);
            const int trf = !trb ? blk : blk < NX5 ? blk : 2 * NX5 + (blk - NX5), trs = !trb ? G : blk < NX5 ? NX5 : G - NX5, trc = !trb ? NTR : blk < NX5 ? 2 * NX5 : NTR;
            if (tr_first) tr_out_phase<1>(trf, trs, trc, p, ldsf);
            { const FftTw w = fft_make_tw(lnd(tid) & 255); u32x4 rr[4]; if (blk < 1024) fourier_rows(blk, p.UCST, rr, lnd(tid));
              for (int c = blk; c < 1024; c += G) fourier_item(c, p.UCST, p.YAT, c + G < 1024 ? c + G : -1, rr, lds, w); }
            if (!last) { for (int c = blk; c < 1024; c += G) fourier_ctx_item(c, p, ldsf); }
            for (int it = blk; it < 16 * NCHUNK; it += G) { u32x2 rq[10], rk[10]; ml_s1_rows(it / NCHUNK, it % NCHUNK, p.Z, rq, rk, lnd(tid));
                ml_s1_item(it / NCHUNK, it % NCHUNK, p.ml_conv_w + (size_t)l * 6 * 1024, p.ml_conv_b + l * 2048, p.Z, p.LI, p.BG, p.MG, p.SPm, p.QSm, p.KSTm, p.DECm, p.CLm, p.VTm, -1, rq, rk, lds); }
            if (!tr_first) tr_out_phase<1>(trf, trs, trc, p, ldsf);
        }
        PHASE_SYNC(ph0 + 3);
        if (PHASE_ON(ph0 + 4)) for (int rep_ = 0; rep_ < PH_REPS(ph0 + 4); ++rep_) { const MP p = mp_load(lp);
            const bool tr_first = (STAGGER & 4) && (((blk >> 3) & 1) != 0);
            if (tr_first) tr_out_phase<0>(blk, G, (MLAT / 64) * 16, p, ldsf);
            for (int it = blk; it < 256; it += G) {
                const int grp = (it & 7) * 4 + ((it >> 3) & 3), slice = it >> 5;
                if (grp < 16) scan_item<0>(grp, slice, p.SPm, p.QSm, p.KSTm, p.VTm, p.DECm, p.CLm, p.OM, lds);
                else scan_item<1>(grp - 16, slice, p.SPg, p.QSg, p.KSTg, p.VTg, p.DECg, nullptr, p.OG, lds);
            }
            if (!tr_first) tr_out_phase<0>(blk, G, (MLAT / 64) * 16, p, ldsf);
        }
        PHASE_SYNC(ph0 + 4);
        if (PHASE_ON(ph0 + 5)) for (int rep_ = 0; rep_ < PH_REPS(ph0 + 5); ++rep_) { const MP p = mp_load(lp);
            const int mrows = last ? MLAT : MROWS;
            { pg8::Gemm g{p.YA, p.fnett + (size_t)l * GW * GW, mrows, GW, GW, GW, GW, 0}; pg8::StaticOrder S; S.init(g, G, blk); EpiFnet2 E{p.Z, p.YCAT}; run_gemm(lds, g, S, E); }
            { const int nun = (mrows / 256) * (GW / 256); const int nfree = G - nun;
              constexpr int CMB_G = 7; const int nit = mrows / 2, ng = nfree > 0 ? nit - CMB_G * nun : 0;
              if (nfree > 0) { if (blk >= nun) combine_phase(blk - nun, nfree, ng, l, p); else combine_phase(ng + blk, nun, nit, l, p); }
              else combine_phase(blk, G, nit, l, p); }
            if (l == 0) { mod_final(1, blk, G, tid, p);
                if (!FILT_IN_TAIL) filter_gemm(1, false, lds, blk, G, p); }
        }
        PHASE_SYNC(ph0 + 5);
        if (PHASE_ON(ph0 + 6)) for (int rep_ = 0; rep_ < PH_REPS(ph0 + 6); ++rep_) { const MP p = mp_load(lp);
            const bool copy_first = (l == 0) && (STAGGER & 1) && ((blk & 1) != 0);
            if (copy_first) pro_wtiles(0, blk, G, T_IN, 1, p, ldsf);
            pg8::Gemm g{p.YCAT, p.woutt + (size_t)l * D * D, MLAT, D, D, D, D, 0}; pg8::StaticOrder S; S.init(g, G, blk); EpiOut2 E{(bf16_t*)p.X1 + (size_t)l * MLAT * D};
            run_gemm(lds, g, S, E);
            if (l == 0) {
                { pg8::Gemm g2{p.YCAT, p.woutt + (size_t)l * D * D, MCTX, D, 512, D, D, 0}; CtxSplitSched S2; S2.G = G; S2.c = blk; S2.A = (const char*)p.YCAT; S2.B = (const char*)(p.woutt + (size_t)l * D * D); EpiCtxPart E2{p.PART}; run_gemm(lds, g2, S2, E2); }
                if (!copy_first) pro_wtiles(0, blk, G, T_IN, 1, p, ldsf); }
        }
        PHASE_SYNC(ph0 + 6);
    #undef PHASE_ON
#undef PHASE_SYNC
}
__global__ __launch_bounds__(512, 2) void mega(MP kp) {
    extern __shared__ __attribute__((aligned(16))) unsigned char shm[];
    LAS unsigned char* lds = (LAS unsigned char*)shm;
    LAS float* ldsf = (LAS float*)shm;
    const int tid = threadIdx.x, blk = blockIdx.x, G = gridDim.x;
    static_assert(sizeof(MP) == 552 && MEGA_PAR_OFF + sizeof(MP) <= MEGA_LDS_BYTES && FFT_LDS_BYTES <= MEGA_BARW_OFF && S1_LDS_BYTES <= MEGA_BARW_OFF && MEGA_LDS_BYTES <= 163840, "LDS map");
    const LAS MP* lp = (const LAS MP*)(lds + MEGA_PAR_OFF);
    if (tid < 4) ((LAS unsigned*)(lds + MEGA_BARW_OFF))[tid] = 0u;
    if (tid == 0) { LAS MP* wp = (LAS MP*)(lds + MEGA_PAR_OFF);
#define MP_ST(T, f) wp->f = kp.f;
        MP_FIELDS(MP_ST)
#undef MP_ST
    }
    __syncthreads();
    XcdBarrier bar = xcd_barrier_post(kp.bar, (volatile LAS unsigned*)(lds + MEGA_BARW_OFF));
    const int pb = kp.ph_begin, pe = kp.ph_end;
#define PHASE_ON(ph) (PH_EN(ph) && (ph) >= pb && (ph) < pe)
#define PHASE_SYNC(ph) do { if ((ph) >= pb && (ph) + 1 < pe) xcd_barrier(bar); } while (0)

    if (PHASE_ON(0)) for (int rep_ = 0; rep_ < PH_REPS(0); ++rep_) { const MP p = mp_load(lp);
        pro_wtiles(0, blk, G, T_L, 0, p, ldsf);
        for (int it = blk; it < ADA_KS * 6; it += G) ada_item(it, p, ldsf);
        for (int it = blk; it < (SEQ + CTXL) / 8; it += G) hid_item(it, p, ldsf);
        for (int i = blk * 512 + lnd(tid); i < PRO_ELEMS; i += G * 512) pro_elem(i, p);
    }
    PHASE_SYNC(0);
    if (PHASE_ON(1)) for (int rep_ = 0; rep_ < PH_REPS(1); ++rep_) { const MP p = mp_load(lp);
        mod_final(0, blk, G, tid, p);
        filter_gemm(0, true, lds, blk, G, p);
    }
    PHASE_SYNC(1);
    layer_phases<0>(lp, lds, ldsf, bar, pb, pe, tid, blk, G);
    layer_phases<1>(lp, lds, ldsf, bar, pb, pe, tid, blk, G);
    if (PHASE_ON(16)) for (int rep_ = 0; rep_ < PH_REPS(16); ++rep_) { const MP p = mp_load(lp); final_phase(blk, G, p, ldsf); }
#undef PHASE_ON
#undef PHASE_SYNC
}

struct WsMap2 { size_t off[64]; size_t end; };
extern "C" void kernel_launch(void* const* d_in, const int* in_sizes, int n_in, void* d_out, int out_size, void* d_ws, size_t ws_size, hipStream_t stream) {
    static int grid = 0; static size_t need = 0; static MP base;
    char* ws = (char*)d_ws;
    if (!grid) {
        int dev = 0, cus = 0, per_cu = 0;
        (void)hipGetDevice(&dev); (void)hipDeviceGetAttribute(&cus, hipDeviceAttributeMultiprocessorCount, dev); if (cus <= 0) cus = 256;
        if (hipFuncSetAttribute((const void*)mega, hipFuncAttributeMaxDynamicSharedMemorySize, MEGA_LDS_BYTES) != hipSuccess) fprintf(stderr, "kernel_launch: hipFuncSetAttribute failed\n");
        if (hipOccupancyMaxActiveBlocksPerMultiprocessor(&per_cu, (const void*)mega, 512, MEGA_LDS_BYTES) != hipSuccess || per_cu < 1) fprintf(stderr, "kernel_launch: occupancy query says %d blocks per CU\n", per_cu);
        grid = cus;
        memset(&base, 0, sizeof(base));
        size_t o = 1u << 20;
        auto take = [&](size_t bytes) { size_t r = o; o += (bytes + 255) & ~(size_t)255; return r; };
#define TAKE(field, type, bytes) base.field = (type*)(size_t)take(bytes)
        TAKE(wint, bf16_t, (size_t)2 * NP * D * 2); TAKE(woutt, bf16_t, (size_t)2 * D * D * 2); TAKE(fnett, bf16_t, (size_t)2 * GW * GW * 2);
        TAKE(H, bf16_t, (size_t)MROWS * D * 2); TAKE(Z, bf16_t, (size_t)MROWS * NP * 2); TAKE(ZT, bf16_t, (size_t)3072 * MROWS * 2); TAKE(YCAT, bf16_t, (size_t)MROWS * D * 2);
        TAKE(YA, bf16_t, (size_t)MROWS * 1024 * 2); TAKE(YAT, bf16_t, (size_t)1024 * MLAT * 2); TAKE(CST, bf16_t, (size_t)512 * 256 * 2); TAKE(WA, bf16_t, (size_t)2 * 4096 * 256 * 2);
        TAKE(HB, bf16_t, (size_t)2 * SEQ * 256 * 2); TAKE(UCST, bf16_t, (size_t)2048 * MROWS * 2); TAKE(HBC, bf16_t, (size_t)2 * CTXL * 256 * 2);
        { const size_t NI = (size_t)16 * NCHUNK; TAKE(SPm, bf16_t, NI * 4096 * 2); TAKE(SPg, bf16_t, NI * 4096 * 2); TAKE(QSm, bf16_t, NI * 64 * 256 * 2); TAKE(QSg, bf16_t, NI * 64 * 128 * 2);
          TAKE(KSTm, bf16_t, NI * 256 * 64 * 2); TAKE(KSTg, bf16_t, NI * 128 * 64 * 2); TAKE(VTm, bf16_t, (size_t)8 * NCHUNK * 256 * 64 * 2); TAKE(VTg, bf16_t, (size_t)8 * NCHUNK * 256 * 64 * 2);
          TAKE(DECm, float, NI * 256 * 4); TAKE(DECg, float, NI * 128 * 4); TAKE(CLm, float, NI * 64 * 4); }
        TAKE(adapart, float, (size_t)2 * ADA_KS * 3 * 3 * D * 4); TAKE(mod, float, (size_t)2 * 9 * D * 4); TAKE(ZG, float, (size_t)MROWS * 256 * 4); TAKE(X1, float, (size_t)MROWS * D * 4);
        TAKE(KT, float, (size_t)2 * 4096 * SEQ * 4); TAKE(KTC, float, (size_t)2 * 4096 * CTXL * 4); TAKE(YBT, float, (size_t)1024 * MLAT * 4);
        TAKE(LI, float, (size_t)16 * SEQP * 4); TAKE(BG, float, (size_t)16 * SEQP * 4); TAKE(MG, float, (size_t)16 * SEQP * 4); TAKE(OM, float, (size_t)2 * MROWS * 1024 * 4); TAKE(OG, float, (size_t)2 * MROWS * 1024 * 4); TAKE(KSCR, float, (size_t)1024 * 16 * 512 * 8); TAKE(KPRE, float, (size_t)NPRE * 2 * 16 * 512 * 8); TAKE(PART, float, (size_t)8 * MCTX * D * 4);
#undef TAKE
        need = o;
    }
    if (ws_size < need || n_in != 26) { fprintf(stderr, "kernel_launch: need %zu bytes of workspace (have %zu), 26 inputs (have %d)\n", need, ws_size, n_in); return; }
    MP p = base;
    {
        bf16_t** bp[] = {&p.wint, &p.woutt, &p.fnett, &p.H, &p.Z, &p.ZT, &p.YCAT, &p.YA, &p.YAT, &p.CST, &p.WA, &p.HB, &p.HBC, &p.SPm, &p.SPg, &p.QSm, &p.QSg, &p.KSTm, &p.KSTg, &p.VTm, &p.VTg, &p.UCST};
        for (auto q : bp) *q = (bf16_t*)(ws + (size_t)*q);
        float** fp[] = {&p.adapart, &p.mod, &p.ZG, &p.X1, &p.KT, &p.KTC, &p.YBT, &p.LI, &p.BG, &p.MG, &p.DECm, &p.DECg, &p.CLm, &p.OM, &p.OG, &p.KSCR, &p.KPRE, &p.PART};
        for (auto q : fp) *q = (float*)(ws + (size_t)*q);
    }
    const float** ins[] = {&p.x, &p.c, &p.ctx, &p.c_ctx, &p.ada_w, &p.ada_b, &p.norm_g, &p.w_in, &p.fnet_w, &p.hy_conv_w, &p.hy_conv_b, &p.hy_f_w1, &p.hy_f_b1, &p.hy_f_w2, &p.hy_f_b2, &p.hy_f_w3, &p.hy_f_freq, &p.hy_bias,
                           &p.ml_conv_w, &p.ml_conv_b, &p.ml_gate_b, &p.gla_w2, &p.gla_b2, &p.gla_norm_g, &p.w_out, &p.final_g};
    for (int i = 0; i < 26; ++i) *ins[i] = (const float*)d_in[i];
    p.out = (float*)d_out; p.bar = (unsigned*)ws;
    (void)hipMemsetAsync(ws, 0, 65536, stream);
#ifndef MEGA_SPLIT
    p.ph_begin = 0; p.ph_end = NPHASE;
    hipLaunchKernelGGL(mega, dim3(grid), dim3(512), MEGA_LDS_BYTES, stream, p);
#else
    for (int ph = 0; ph < NPHASE; ++ph) { p.ph_begin = ph; p.ph_end = ph + 1; hipLaunchKernelGGL(mega, dim3(grid), dim3(512), MEGA_LDS_BYTES, stream, p); }
#endif
}
```
